# Optimizing an MI355X kernel written in HIP

```python
import math
import jax, jax.numpy as jnp
from jax import lax
import numpy as np

D_MODEL = 1024
BATCH = 8
SEQ = 4096
DEPTH = 2

HEAD_DIM = 64
HEADS_A = 8
VDIM_A = 2 * HEAD_DIM
WIDTH_A = HEADS_A * VDIM_A
DILATED_GROUPS = ((128, 1), (512, 4), (2048, 16))
N_GROUPS_B = 3
HEADS_PER_GROUP_B = 4
HEADS_B = N_GROUPS_B * HEADS_PER_GROUP_B
WIDTH_B = HEADS_PER_GROUP_B * HEAD_DIM
D_FF = 4 * D_MODEL
ROPE_THETA = 500000.0
ROT_FRACTION = 4
Q_BLOCK = 128
EPS = 1e-6
NEG_INF = -1e30
Q_A_COLS = HEADS_A * 2 * HEAD_DIM
K_A_COLS = HEADS_A * 2 * HEAD_DIM
V_A_COLS = HEADS_A * VDIM_A
QKV_B_COLS = HEADS_B * HEAD_DIM
GATE_COLS = 2 * D_MODEL
IN_COLS = Q_A_COLS + K_A_COLS + V_A_COLS + 3 * QKV_B_COLS + GATE_COLS
IN_SPLITS = (
    Q_A_COLS,
    Q_A_COLS + K_A_COLS,
    Q_A_COLS + K_A_COLS + V_A_COLS,
    Q_A_COLS + K_A_COLS + V_A_COLS + QKV_B_COLS,
    Q_A_COLS + K_A_COLS + V_A_COLS + 2 * QKV_B_COLS,
    Q_A_COLS + K_A_COLS + V_A_COLS + 3 * QKV_B_COLS,
)

kernel_name = "hybrid_diffattn_dilated_encoder"


def rms_norm(x, g):
    xf = x.astype(jnp.float32)
    y = xf * lax.rsqrt(jnp.mean(xf * xf, axis=-1, keepdims=True) + EPS)
    return (y * g.astype(jnp.float32)).astype(x.dtype)


def rope_tables(positions):
    rot = HEAD_DIM // ROT_FRACTION
    inv_freq = ROPE_THETA ** (-jnp.arange(0, rot, 2, dtype=jnp.float32) / rot)
    ang = positions.astype(jnp.float32)[..., None] * inv_freq
    return jnp.cos(ang), jnp.sin(ang)


def apply_rope(x, cos, sin):
    half = cos.shape[-1]
    bshape = cos.shape[:2] + (1,) * (x.ndim - 3) + (half,)
    cs = cos.reshape(bshape).astype(x.dtype)
    sn = sin.reshape(bshape).astype(x.dtype)
    x1, x2, rest = x[..., :half], x[..., half:2 * half], x[..., 2 * half:]
    return jnp.concatenate([x1 * cs - x2 * sn, x2 * cs + x1 * sn, rest], axis=-1)


def diff_attention(q, k, v, lam):
    b, s, h, _, dh = q.shape
    nq = s // Q_BLOCK
    scale = dh ** -0.5
    qb = q.reshape(b, nq, Q_BLOCK, h, 2, dh).transpose(1, 0, 3, 4, 2, 5)
    kt = k.transpose(0, 2, 3, 1, 4)
    vt = v.transpose(0, 2, 1, 3)

    def block(qblk):
        sc = jnp.einsum('bhcqd,bhckd->bhcqk', qblk, kt).astype(jnp.float32) * scale
        p = jax.nn.softmax(sc, axis=-1)
        w = p[:, :, 0] - lam * p[:, :, 1]
        return jnp.einsum('bhqk,bhkd->bhqd', w.astype(vt.dtype), vt)

    o = lax.map(block, qb)
    return o.transpose(1, 0, 3, 2, 4).reshape(b, s, h, 2 * dh)


def dilated_window_attention(q, k, v, dilation, side):
    b, s, h, dh = q.shape
    L = s // dilation
    nb = -(-L // side)
    Lp = nb * side

    def split(t):
        return t.reshape(b, L, dilation, h, dh).transpose(0, 2, 3, 1, 4)

    qs = jnp.pad(split(q), ((0, 0),) * 3 + ((0, Lp - L), (0, 0)))
    pad_kv = ((0, 0),) * 3 + ((side, Lp - L + side), (0, 0))
    kp = jnp.pad(split(k), pad_kv)
    vp = jnp.pad(split(v), pad_kv)

    def band(t):
        return jnp.concatenate(
            [t[..., j * side:j * side + Lp, :].reshape(b, dilation, h, nb, side, dh) for j in range(3)],
            axis=-2)

    kb, vb = band(kp), band(vp)
    qb = qs.reshape(b, dilation, h, nb, side, dh)
    sc = jnp.einsum('bghnqd,bghnkd->bghnqk', qb, kb).astype(jnp.float32) * (dh ** -0.5)
    blk = jnp.arange(nb)[:, None, None]
    qpos = blk * side + jnp.arange(side)[None, :, None]
    kpos = blk * side - side + jnp.arange(3 * side)[None, None, :]
    valid = (jnp.abs(qpos - kpos) <= side) & (kpos >= 0) & (kpos < L)
    sc = jnp.where(valid, sc, NEG_INF)
    lse = jax.nn.logsumexp(sc, axis=-1)
    p = jnp.exp(sc - lse[..., None])
    o = jnp.einsum('bghnqk,bghnkd->bghnqd', p.astype(v.dtype), vb)
    o = o.reshape(b, dilation, h, Lp, dh)[..., :L, :].transpose(0, 3, 1, 2, 4).reshape(b, s, h, dh)
    lse = lse.reshape(b, dilation, h, Lp)[..., :L].transpose(0, 3, 1, 2).reshape(b, s, h)
    return o, lse


def setup_inputs(seed: int = 0) -> dict:
    key = jax.random.key(seed)
    ks = jax.random.split(key, 20)
    D = D_MODEL
    nrm = lambda k, shape, s: jax.random.normal(k, shape, jnp.float32) * s
    x = nrm(ks[0], (BATCH, SEQ, D), 1.0)
    c = nrm(ks[1], (BATCH, D), 1.0)
    offsets = jax.random.randint(ks[2], (BATCH, 1), 0, 1024, dtype=jnp.int32)
    positions = (jnp.arange(SEQ, dtype=jnp.int32)[None, :] + offsets).astype(jnp.int32)
    return {
        "x": x,
        "c": c,
        "positions": positions,
        "ada_w": nrm(ks[3], (DEPTH, D, 6 * D), D ** -0.5),
        "ada_b": nrm(ks[4], (DEPTH, 6 * D), 0.02),
        "norm_mix_g": 1.0 + nrm(ks[5], (DEPTH, D), 0.02),
        "norm_mlp_g": 1.0 + nrm(ks[6], (DEPTH, D), 0.02),
        "w_in": nrm(ks[7], (DEPTH, D, IN_COLS), D ** -0.5),
        "qk_gain_a": 1.0 + nrm(ks[8], (DEPTH, 2, HEAD_DIM), 0.02),
        "lambda_a": nrm(ks[9], (DEPTH, 4, HEAD_DIM), 0.1),
        "subln_g_a": 1.0 + nrm(ks[10], (DEPTH, VDIM_A), 0.02),
        "qk_gain_b": 1.0 + nrm(ks[11], (DEPTH, 2, HEAD_DIM), 0.02),
        "w_branch_a": nrm(ks[12], (DEPTH, WIDTH_A, D), WIDTH_A ** -0.5),
        "w_branch_b": nrm(ks[13], (DEPTH, WIDTH_B, D), WIDTH_B ** -0.5),
        "gate_bias": nrm(ks[14], (DEPTH, GATE_COLS), 0.02),
        "w_out": nrm(ks[15], (DEPTH, D, D), D ** -0.5),
        "w_mlp_up": nrm(ks[16], (DEPTH, D, D_FF), D ** -0.5),
        "w_mlp_down": nrm(ks[17], (DEPTH, D_FF, D), D_FF ** -0.5),
    }


def reference(x, c, positions, ada_w, ada_b, norm_mix_g, norm_mlp_g, w_in, qk_gain_a,
              lambda_a, subln_g_a, qk_gain_b, w_branch_a, w_branch_b, gate_bias, w_out,
              w_mlp_up, w_mlp_down):
    b, s, _ = x.shape
    cos, sin = rope_tables(positions)
    cond = jax.nn.silu(c)
    for l in range(DEPTH):
        mod = (cond @ ada_w[l] + ada_b[l])[:, None, :]
        shift_m, scale_m, gate_m, shift_f, scale_f, gate_f = jnp.split(mod, 6, axis=-1)

        h = rms_norm(x, norm_mix_g[l]) * (1.0 + scale_m) + shift_m
        proj = h @ w_in[l]
        qa, ka, va, qb, kb, vb, gates = jnp.split(proj, IN_SPLITS, axis=-1)

        qa = apply_rope(rms_norm(qa.reshape(b, s, HEADS_A, 2, HEAD_DIM), qk_gain_a[l, 0]), cos, sin)
        ka = apply_rope(rms_norm(ka.reshape(b, s, HEADS_A, 2, HEAD_DIM), qk_gain_a[l, 1]), cos, sin)
        va = va.reshape(b, s, HEADS_A, VDIM_A)
        lam_init = 0.8 - 0.6 * math.exp(-0.3 * l)
        lv = lambda_a[l].astype(jnp.float32)
        lam = jnp.exp(jnp.sum(lv[0] * lv[1])) - jnp.exp(jnp.sum(lv[2] * lv[3])) + lam_init
        oa = diff_attention(qa, ka, va, lam)
        oa = (rms_norm(oa, subln_g_a[l]) * (1.0 - lam_init)).reshape(b, s, WIDTH_A)

        qb = apply_rope(rms_norm(qb.reshape(b, s, N_GROUPS_B, HEADS_PER_GROUP_B, HEAD_DIM), qk_gain_b[l, 0]), cos, sin)
        kb = apply_rope(rms_norm(kb.reshape(b, s, N_GROUPS_B, HEADS_PER_GROUP_B, HEAD_DIM), qk_gain_b[l, 1]), cos, sin)
        vb = vb.reshape(b, s, N_GROUPS_B, HEADS_PER_GROUP_B, HEAD_DIM)
        outs, lses = [], []
        for g, (window, dilation) in enumerate(DILATED_GROUPS):
            o_g, lse_g = dilated_window_attention(qb[:, :, g], kb[:, :, g], vb[:, :, g],
                                                  dilation, window // (2 * dilation))
            outs.append(o_g)
            lses.append(lse_g)
        wgt = jax.nn.softmax(jnp.stack(lses, axis=0), axis=0)
        ob = jnp.sum(wgt[..., None].astype(x.dtype) * jnp.stack(outs, axis=0), axis=0)
        ob = ob.reshape(b, s, WIDTH_B)

        g_a, g_b = jnp.split(jax.nn.sigmoid(gates + gate_bias[l]), 2, axis=-1)
        y = (g_a * (oa @ w_branch_a[l]) + g_b * (ob @ w_branch_b[l])) @ w_out[l]
        x = x + gate_m * y

        h = rms_norm(x, norm_mlp_g[l]) * (1.0 + scale_f) + shift_f
        x = x + gate_f * (jnp.square(jax.nn.relu(h @ w_mlp_up[l])) @ w_mlp_down[l])
    return x
```

```cpp
#include <hip/hip_runtime.h>
#include <hip/hip_cooperative_groups.h>
#include <cstdio>
#include <cstdint>
__device__ __forceinline__ int fresh_lane() { int l; asm volatile("v_mbcnt_lo_u32_b32 %0, -1, 0\n\tv_mbcnt_hi_u32_b32 %0, -1, %0" : "=v"(l)); return l; }
template <int K> __device__ __forceinline__ float shx(float v) { return __int_as_float(__builtin_amdgcn_ds_swizzle(__float_as_int(v), (K << 10) | 0x1f)); }
__device__ __forceinline__ float add_x32(float v) { auto rr = __builtin_amdgcn_permlane32_swap(__float_as_uint(v), __float_as_uint(v), false, false); return __uint_as_float(rr[0]) + __uint_as_float(rr[1]); }
__device__ __forceinline__ float max_x32(float v) { auto rr = __builtin_amdgcn_permlane32_swap(__float_as_uint(v), __float_as_uint(v), false, false); return fmaxf(__uint_as_float(rr[0]), __uint_as_float(rr[1])); }
namespace pg8 {
#define PG8_LAS __attribute__((address_space(3)))
typedef unsigned short bf16_t;
typedef short bf16x8 __attribute__((ext_vector_type(8)));
typedef float f32x4 __attribute__((ext_vector_type(4)));
typedef unsigned u32x4 __attribute__((ext_vector_type(4)));
constexpr int BM = 256, BK = 64, HALF = 128, HTB = HALF * BK * 2  , STAGE_BYTES = 8 * HTB, NXCD = 8, WGM = 8;

__host__ __device__ __forceinline__ int lds_byte(int r, int c) { const int st = (r >> 4) * 2 + (c >> 5), rr = r & 15, cc = c & 31, ob = rr * 64 + cc * 2; return st * 1024 + (ob ^ (((ob >> 9) & 1) << 5)); }
__host__ __device__ __forceinline__ void stage_rc(int b, int& R, int& C) { const int st = b / 1024, sb = b % 1024, swz = sb ^ (((sb >> 9) & 1) << 5); R = (st >> 1) * 16 + swz / 64; C = (st & 1) * 32 + (swz % 64) / 2; }
__host__ __device__ __forceinline__ int perm32(int rho) { const int n = rho >> 4, i = rho & 15; return 8 * (i >> 2) + 4 * n + (i & 3); }

struct Unit { int pm, pn; };
struct Gemm { const bf16_t* A; const bf16_t* Bt; int M, N, K; };

struct StaticOrder {
    int nM, nN, nwg, G, c;
    __host__ __device__ void init(int M, int N, int G_, int c_) { nM = M / BM; nN = N / BM; nwg = nM * nN; G = G_; c = c_; }
    __host__ __device__ bool next(int i, Unit& u) const {
        const long L = (long)i * G + c; if (L >= nwg) return false;
        int wgid = (int)L; { const int q = nwg / NXCD, r = nwg % NXCD, xcd = wgid % NXCD, off = wgid / NXCD; wgid = (xcd < r ? xcd * (q + 1) : r * (q + 1) + (xcd - r) * q) + off; }
        const int nig = WGM * nN, gid = wgid / nig, fm = gid * WGM, gsz = (nM - fm) < WGM ? (nM - fm) : WGM;
        u.pm = fm + ((wgid % nig) % gsz); u.pn = (wgid % nig) / gsz; return true;
    }
    __device__ __forceinline__ void a_ready(const Unit&) const {}
    __device__ __forceinline__ void done(const Unit&) const {}
};

__device__ __forceinline__ unsigned cvt_pk_bf16(float lo, float hi) { unsigned r; asm volatile("v_cvt_pk_bf16_f32 %0, %1, %2" : "=v"(r) : "v"(lo), "v"(hi)); return r; }
typedef float f32x2 __attribute__((ext_vector_type(2)));

__device__ __forceinline__ u32x4 pack8(const f32x4 a, const f32x4 b) { u32x4 w; w.x = cvt_pk_bf16(a[0], a[1]); w.y = cvt_pk_bf16(a[2], a[3]); w.z = cvt_pk_bf16(b[0], b[1]); w.w = cvt_pk_bf16(b[2], b[3]); return w; }
__device__ __forceinline__ void unpack8(const u32x4 w, f32x4& a, f32x4& b) {
    a[0] = __uint_as_float(w.x << 16); a[1] = __uint_as_float(w.x & 0xffff0000u); a[2] = __uint_as_float(w.y << 16); a[3] = __uint_as_float(w.y & 0xffff0000u);
    b[0] = __uint_as_float(w.z << 16); b[1] = __uint_as_float(w.z & 0xffff0000u); b[2] = __uint_as_float(w.w << 16); b[3] = __uint_as_float(w.w & 0xffff0000u); }
constexpr float QK_C2 = 0.125f * 1.4426950408889634f;
constexpr float RMS_EPS = 1e-6f;

struct EpiQKV {
    static constexpr bool PERM = true, AFTER_DRAIN = false;
    bf16_t *QA, *KA, *VA, *QB, *KB, *VB;
    const float* rowss;
    const float* sb;
    const float* gain_a;
    const float* gain_b;
    const float* cs; const float* sn;
    __device__ __forceinline__ void operator()(const f32x4 (&acc)[2][2][4][2], const Unit& u, int wr, int wc, int fr, int fq) const {
        const int tile = u.pn, b = u.pm >> 4;
        bf16_t* dst; int ld, ctile; int kind;
        const float* gain;
        if (tile < 4)       { dst = QA; ld = 1024; ctile = tile;      kind = 0; gain = gain_a; }
        else if (tile < 8)  { dst = KA; ld = 1024; ctile = tile - 4;  kind = 1; gain = gain_a + 64; }
        else if (tile < 12) { dst = VA; ld = 1024; ctile = tile - 8;  kind = 2; gain = gain_a; }
        else if (tile < 15) { dst = QB; ld = 768;  ctile = tile - 12; kind = 0; gain = gain_b; }
        else if (tile < 18) { dst = KB; ld = 768;  ctile = tile - 15; kind = 1; gain = gain_b + 64; }
        else                { dst = VB; ld = 768;  ctile = tile - 18; kind = 2; gain = gain_b; }
        const int oc0 = 64 * wc + 8 * fq;
        f32x4 bv[2][2], gv[2][2];
#pragma unroll
        for (int bj = 0; bj < 2; ++bj)
#pragma unroll
            for (int n = 0; n < 2; ++n) {
                bv[bj][n] = *(const f32x4*)(sb + (size_t)b * 7424 + tile * 256 + oc0 + 32 * bj + 4 * n);
                gv[bj][n] = *(const f32x4*)(gain + 32 * bj + 8 * fq + 4 * n);
            }
        const float qs = (kind == 0) ? QK_C2 : 1.0f;
#pragma unroll
        for (int ai = 0; ai < 2; ++ai)
#pragma unroll
            for (int m = 0; m < 4; ++m) {
                const int row = u.pm * BM + ai * HALF + wr * 64 + m * 16 + fr;
                const float rinv = __builtin_amdgcn_rsqf(rowss[row] * (1.0f / 1024.0f) + RMS_EPS);
                f32x4 v[2][2];
#pragma unroll
                for (int bj = 0; bj < 2; ++bj)
#pragma unroll
                    for (int n = 0; n < 2; ++n) v[bj][n] = acc[ai][bj][m][n] * rinv + bv[bj][n];
                if (kind != 2) {
                    float ss = 0.f;
#pragma unroll
                    for (int bj = 0; bj < 2; ++bj)
#pragma unroll
                        for (int n = 0; n < 2; ++n) { const f32x4 x = v[bj][n]; ss += (x[0] * x[0] + x[1] * x[1]) + (x[2] * x[2] + x[3] * x[3]); }
                    ss += shx<16>(ss); ss = add_x32(ss);
                    const float rr = __builtin_amdgcn_rsqf(ss * (1.0f / 64.0f) + RMS_EPS) * qs;
#pragma unroll
                    for (int bj = 0; bj < 2; ++bj)
#pragma unroll
                        for (int n = 0; n < 2; ++n) v[bj][n] = v[bj][n] * gv[bj][n] * rr;
#pragma unroll
                    for (int n = 0; n < 2; ++n) {
                        const f32x4 c4 = *(const f32x4*)(cs + (size_t)row * 8 + 4 * n), s4 = *(const f32x4*)(sn + (size_t)row * 8 + 4 * n);
                        f32x4 pr;
#pragma unroll
                        for (int e = 0; e < 4; ++e) pr[e] = shx<16>(v[0][n][e]);
                        if (fq == 0) v[0][n] = v[0][n] * c4 - pr * s4;
                        else if (fq == 1) v[0][n] = v[0][n] * c4 + pr * s4;
                    }
                }
                bf16_t* rowp = dst + (size_t)row * ld + ctile * 256 + oc0;
                *(u32x4*)(rowp) = pack8(v[0][0], v[0][1]);
                *(u32x4*)(rowp + 32) = pack8(v[1][0], v[1][1]);
            }
    }
};

template <bool F32OUT> struct EpiGate {
    static constexpr bool PERM = true, AFTER_DRAIN = false;
    void* out; const float* rowss; const float* sb; const float* gbias;
    __device__ __forceinline__ void operator()(const f32x4 (&acc)[2][2][4][2], const Unit& u, int wr, int wc, int fr, int fq) const {
        const int b = u.pm >> 4; const int col0 = u.pn * BM + wc * 32 + 8 * fq;
        f32x4 bv[2][2];
#pragma unroll
        for (int bj = 0; bj < 2; ++bj)
#pragma unroll
            for (int n = 0; n < 2; ++n) bv[bj][n] = *(const f32x4*)(sb + (size_t)b * 7424 + col0 + bj * HALF + 4 * n) + *(const f32x4*)(gbias + col0 + bj * HALF + 4 * n);
#pragma unroll
        for (int ai = 0; ai < 2; ++ai)
#pragma unroll
            for (int m = 0; m < 4; ++m) {
                const int row = u.pm * BM + ai * HALF + wr * 64 + m * 16 + fr;
                const float rinv = __builtin_amdgcn_rsqf(rowss[row] * (1.0f / 1024.0f) + RMS_EPS);
#pragma unroll
                for (int bj = 0; bj < 2; ++bj) {
                    f32x4 v[2];
#pragma unroll
                    for (int n = 0; n < 2; ++n) { const f32x4 z = acc[ai][bj][m][n] * rinv + bv[bj][n];
#pragma unroll
                        for (int e = 0; e < 4; ++e) v[n][e] = __builtin_amdgcn_rcpf(1.0f + __builtin_amdgcn_exp2f(-1.4426950408889634f * z[e])); }
                    const size_t off = (size_t)row * 1024 + col0 + bj * HALF;
                    if (F32OUT) { *(f32x4*)((float*)out + off) = v[0]; *(f32x4*)((float*)out + off + 4) = v[1]; }
                    else *(u32x4*)((bf16_t*)out + off) = pack8(v[0], v[1]);
                }
            }
    }
};
struct EpiMulInPlace {
    static constexpr bool PERM = true, AFTER_DRAIN = false;
    bf16_t* tmp;
    __device__ __forceinline__ void operator()(const f32x4 (&acc)[2][2][4][2], const Unit& u, int wr, int wc, int fr, int fq) const {
        const int col0 = u.pn * BM + wc * 32 + 8 * fq;
#pragma unroll
        for (int ai = 0; ai < 2; ++ai)
#pragma unroll
            for (int m = 0; m < 4; ++m) {
                const int row = u.pm * BM + ai * HALF + wr * 64 + m * 16 + fr;
#pragma unroll
                for (int bj = 0; bj < 2; ++bj) { bf16_t* p = tmp + (size_t)row * 1024 + col0 + bj * HALF;
                    f32x4 t0, t1; unpack8(*(const u32x4*)p, t0, t1);
                    *(u32x4*)p = pack8(t0 * acc[ai][bj][m][0], t1 * acc[ai][bj][m][1]); }
            }
    }
};
struct EpiMerge {
    static constexpr bool PERM = true, AFTER_DRAIN = false;
    const bf16_t* tmp1; const bf16_t* ga; bf16_t* U;
    __device__ __forceinline__ void operator()(const f32x4 (&acc)[2][2][4][2], const Unit& u, int wr, int wc, int fr, int fq) const {
        const int col0 = u.pn * BM + wc * 32 + 8 * fq;
#pragma unroll
        for (int ai = 0; ai < 2; ++ai)
#pragma unroll
            for (int m = 0; m < 4; ++m) {
                const int row = u.pm * BM + ai * HALF + wr * 64 + m * 16 + fr;
#pragma unroll
                for (int bj = 0; bj < 2; ++bj) { const size_t off = (size_t)row * 1024 + col0 + bj * HALF;
                    f32x4 t0, t1, g0, g1; unpack8(*(const u32x4*)(tmp1 + off), t0, t1); unpack8(*(const u32x4*)(ga + off), g0, g1);
                    *(u32x4*)(U + off) = pack8(g0 * acc[ai][bj][m][0] + t0, g1 * acc[ai][bj][m][1] + t1); }
            }
    }
};
struct EpiResid {
    static constexpr bool PERM = true, AFTER_DRAIN = false;
    const float* xi; float* xo; const float* gate;
    bf16_t* xs; const float* ng; const float* scl; float* rowss;
    __device__ __forceinline__ void operator()(const f32x4 (&acc)[2][2][4][2], const Unit& u, int wr, int wc, int fr, int fq) const {
        const int b = u.pm >> 4; const int col0 = u.pn * BM + wc * 32 + 8 * fq;
        f32x4 gt[2][2], gs[2][2];
#pragma unroll
        for (int bj = 0; bj < 2; ++bj)
#pragma unroll
            for (int n = 0; n < 2; ++n) { const int c = col0 + bj * HALF + 4 * n;
                gt[bj][n] = *(const f32x4*)(gate + (size_t)b * 6144 + c);
                if (xs) gs[bj][n] = *(const f32x4*)(ng + c) * (*(const f32x4*)(scl + (size_t)b * 6144 + c) + 1.0f); else gs[bj][n] = (f32x4){0.f, 0.f, 0.f, 0.f}; }
#pragma unroll
        for (int ai = 0; ai < 2; ++ai)
#pragma unroll
            for (int m = 0; m < 4; ++m) {
                const int row = u.pm * BM + ai * HALF + wr * 64 + m * 16 + fr;
                float ss = 0.f;
#pragma unroll
                for (int bj = 0; bj < 2; ++bj) { const size_t off = (size_t)row * 1024 + col0 + bj * HALF;
                    const f32x4 x0 = *(const f32x4*)(xi + off) + gt[bj][0] * acc[ai][bj][m][0], x1 = *(const f32x4*)(xi + off + 4) + gt[bj][1] * acc[ai][bj][m][1];
                    *(f32x4*)(xo + off) = x0; *(f32x4*)(xo + off + 4) = x1;
                    if (xs) { ss += (x0[0] * x0[0] + x0[1] * x0[1]) + (x0[2] * x0[2] + x0[3] * x0[3]) + (x1[0] * x1[0] + x1[1] * x1[1]) + (x1[2] * x1[2] + x1[3] * x1[3]);
                        *(u32x4*)(xs + off) = pack8(x0 * gs[bj][0], x1 * gs[bj][1]); } }
                if (xs) { ss += shx<16>(ss); ss = add_x32(ss); if (fq == 0) atomicAdd(rowss + row, ss); }
            }
    }
};
struct EpiUp {
    static constexpr bool PERM = true, AFTER_DRAIN = false;
    bf16_t* H; const float* rowss; const float* sb;
    __device__ __forceinline__ void operator()(const f32x4 (&acc)[2][2][4][2], const Unit& u, int wr, int wc, int fr, int fq) const {
        const int b = u.pm >> 4; const int col0 = u.pn * BM + wc * 32 + 8 * fq;
        f32x4 bv[2][2];
#pragma unroll
        for (int bj = 0; bj < 2; ++bj)
#pragma unroll
            for (int n = 0; n < 2; ++n) bv[bj][n] = *(const f32x4*)(sb + (size_t)b * 4096 + col0 + bj * HALF + 4 * n);
#pragma unroll
        for (int ai = 0; ai < 2; ++ai)
#pragma unroll
            for (int m = 0; m < 4; ++m) {
                const int row = u.pm * BM + ai * HALF + wr * 64 + m * 16 + fr;
                const float rinv = __builtin_amdgcn_rsqf(rowss[row] * (1.0f / 1024.0f) + RMS_EPS);
#pragma unroll
                for (int bj = 0; bj < 2; ++bj) {
                    f32x4 v[2];
#pragma unroll
                    for (int n = 0; n < 2; ++n) { f32x4 z = acc[ai][bj][m][n] * rinv + bv[bj][n];
#pragma unroll
                        for (int e = 0; e < 4; ++e) { const float r = fmaxf(z[e], 0.f); z[e] = r * r; } v[n] = z; }
                    *(u32x4*)(H + (size_t)row * 4096 + col0 + bj * HALF) = pack8(v[0], v[1]);
                }
            }
    }
};
template <class Epi, class Sched, bool ALIGN_EPI = false, bool SP2 = false>
__device__ __forceinline__ void gemm_phase(PG8_LAS unsigned char* lds, const Gemm g, const Sched& S, const Epi& E, const int wid0) {
    const int tid_ = wid0 * 64 + fresh_lane();
    const int tid = tid_, wid = __builtin_amdgcn_readfirstlane(tid >> 6), lane = tid & 63, wr = wid >> 2, wc = wid & 3, fr = lane & 15, fq = lane >> 4;
    const int K = g.K, nt = K / BK;
    unsigned voffA[2], voffB[2];
#pragma unroll
    for (int i = 0; i < 2; ++i) { int R, C; stage_rc(tid * 16 + i * 8192, R, C); const int Rb = Epi::PERM ? ((R & ~31) + perm32(R & 31)) : R;
        voffA[i] = (unsigned)(R * K + C) * 2u; voffB[i] = (unsigned)(Rb * K + C) * 2u; }
    const size_t kstep = (size_t)(BK * 2);
    const size_t hstep = (size_t)HALF * K * 2;
    const size_t tstep = 2 * hstep;
    const unsigned ldsw = (unsigned)wid * 1024u;
    const int aoff = lds_byte(wr * 64 + fr, fq * 8), boff = lds_byte(wc * 32 + fr, fq * 8);
#define PG8_SA(b, h) (((b) * 2 + (h)) * HTB)
#define PG8_SB(b, h) ((4 + (b) * 2 + (h)) * HTB)
#define PG8_STAGE(bufoff, gbase, voff) do { _Pragma("unroll") for (int _i = 0; _i < 2; ++_i) \
        __builtin_amdgcn_global_load_lds((const unsigned*)((const char*)(gbase) + (voff)[_i]), (PG8_LAS unsigned*)(lds + (bufoff) + ldsw + _i * 8192), 16, 0, 0); } while (0)
#define PG8_LDA(dst, b, h) do { _Pragma("unroll") for (int m = 0; m < 4; ++m) _Pragma("unroll") for (int k = 0; k < 2; ++k) dst[m][k] = *(const PG8_LAS bf16x8*)(lds + PG8_SA(b, h) + aoff + m * 2048 + k * 1024); } while (0)
#define PG8_LDB(dst, b, h) do { _Pragma("unroll") for (int n = 0; n < 2; ++n) _Pragma("unroll") for (int k = 0; k < 2; ++k) dst[n][k] = *(const PG8_LAS bf16x8*)(lds + PG8_SB(b, h) + boff + n * 2048 + k * 1024); } while (0)
#define PG8_MMA(ai, bj, At, Bt) do { __builtin_amdgcn_s_setprio(1); _Pragma("unroll") for (int m = 0; m < 4; ++m) _Pragma("unroll") for (int n = 0; n < 2; ++n) _Pragma("unroll") for (int k = 0; k < 2; ++k) \
        acc[ai][bj][m][n] = __builtin_amdgcn_mfma_f32_16x16x32_bf16(Bt[n][k], At[m][k], acc[ai][bj][m][n], 0, 0, 0); __builtin_amdgcn_s_setprio(0); } while (0)
#define PG8_WAIT_V(n) asm volatile("s_waitcnt vmcnt(" #n ")" ::: "memory")
#define PG8_WAIT_L(n) asm volatile("s_waitcnt lgkmcnt(" #n ")" ::: "memory")
#define PG8_BAR __builtin_amdgcn_s_barrier()
#define PG8_SCHED __builtin_amdgcn_sched_barrier(0)
    Unit cur, nxt; int ui = 0;
    if (!S.next(0, cur)) return;
    f32x4 acc[2][2][4][2];
#pragma unroll
    for (int a = 0; a < 2; ++a)
#pragma unroll
        for (int b = 0; b < 2; ++b)
#pragma unroll
            for (int m = 0; m < 4; ++m)
#pragma unroll
                for (int n = 0; n < 2; ++n) acc[a][b][m][n] = (f32x4){0.f, 0.f, 0.f, 0.f};
    bf16x8 At[4][2], B0[2][2], B1[2][2];
    const char* cA = (const char*)g.A + (size_t)cur.pm * tstep; const char* cB = (const char*)g.Bt + (size_t)cur.pn * tstep;
    S.a_ready(cur);
    if constexpr (SP2) {
        PG8_STAGE(PG8_SB(0, 0), cB, voffB); PG8_STAGE(PG8_SB(0, 1), cB + hstep, voffB); PG8_STAGE(PG8_SA(0, 0), cA, voffA); PG8_STAGE(PG8_SA(0, 1), cA + hstep, voffA);
        if (wr == 1) PG8_BAR;
        PG8_WAIT_V(2); PG8_BAR;
        PG8_STAGE(PG8_SB(1, 0), cB + kstep, voffB); PG8_STAGE(PG8_SA(1, 0), cA + kstep, voffA); PG8_STAGE(PG8_SB(1, 1), cB + hstep + kstep, voffB);
        PG8_WAIT_V(6); PG8_BAR;
    } else {
        PG8_STAGE(PG8_SB(0, 0), cB, voffB); PG8_STAGE(PG8_SA(0, 0), cA, voffA); PG8_STAGE(PG8_SB(0, 1), cB + hstep, voffB); PG8_STAGE(PG8_SA(0, 1), cA + hstep, voffA);
        if (wr == 1) PG8_BAR;
        PG8_WAIT_V(4); PG8_BAR;
        PG8_STAGE(PG8_SB(1, 0), cB + kstep, voffB); PG8_STAGE(PG8_SA(1, 0), cA + kstep, voffA); PG8_STAGE(PG8_SB(1, 1), cB + hstep + kstep, voffB);
        PG8_WAIT_V(6); PG8_BAR;
    }
    for (;;) {
        const bool has_next = S.next(ui + 1, nxt);
        const char* nA = has_next ? (const char*)g.A + (size_t)nxt.pm * tstep : cA; const char* nB = has_next ? (const char*)g.Bt + (size_t)nxt.pn * tstep : cB;
        for (int t = 0; t < nt; t += 2) {
            const bool last = (t == nt - 2);
            const char* a1 = cA + (size_t)(t + 1) * kstep;
            const char* a2 = last ? nA : cA + (size_t)(t + 2) * kstep; const char* b2 = last ? nB : cB + (size_t)(t + 2) * kstep;
            const char* a3 = a2 + kstep; const char* b3 = b2 + kstep;
            if (last && has_next) S.a_ready(nxt);
            if constexpr (SP2) {
            PG8_LDB(B0, 0, 0); PG8_LDB(B1, 0, 1); PG8_SCHED; PG8_LDA(At, 0, 0); PG8_STAGE(PG8_SA(1, 1), a1 + hstep, voffA);
            PG8_WAIT_V(8); PG8_WAIT_L(0); PG8_BAR; PG8_MMA(0, 0, At, B0); PG8_MMA(0, 1, At, B1); PG8_BAR; PG8_SCHED;
            PG8_LDA(At, 0, 1); PG8_STAGE(PG8_SB(0, 0), b2, voffB); PG8_STAGE(PG8_SB(0, 1), b2 + hstep, voffB); PG8_STAGE(PG8_SA(0, 0), a2, voffA);
            PG8_WAIT_V(8); PG8_WAIT_L(0); PG8_BAR; PG8_MMA(1, 0, At, B0); PG8_MMA(1, 1, At, B1); PG8_BAR; PG8_SCHED;
            PG8_LDB(B0, 1, 0); PG8_LDB(B1, 1, 1); PG8_SCHED; PG8_LDA(At, 1, 0); PG8_STAGE(PG8_SA(0, 1), a2 + hstep, voffA);
            PG8_WAIT_V(8); PG8_WAIT_L(0); PG8_BAR; PG8_MMA(0, 0, At, B0); PG8_MMA(0, 1, At, B1); PG8_BAR; PG8_SCHED;
            PG8_LDA(At, 1, 1); PG8_STAGE(PG8_SB(1, 0), b3, voffB); PG8_STAGE(PG8_SB(1, 1), b3 + hstep, voffB); PG8_STAGE(PG8_SA(1, 0), a3, voffA);
            PG8_WAIT_V(8); PG8_WAIT_L(0); PG8_BAR; PG8_MMA(1, 0, At, B0); PG8_MMA(1, 1, At, B1); PG8_BAR; PG8_SCHED;
            } else {
            PG8_LDB(B0, 0, 0); PG8_SCHED; PG8_LDA(At, 0, 0); PG8_STAGE(PG8_SA(1, 1), a1 + hstep, voffA);
            PG8_WAIT_L(8); PG8_BAR; PG8_WAIT_L(0); PG8_MMA(0, 0, At, B0); PG8_BAR; PG8_SCHED;
            PG8_LDB(B1, 0, 1); PG8_STAGE(PG8_SB(0, 0), b2, voffB);
            PG8_BAR; PG8_WAIT_L(0); PG8_MMA(0, 1, At, B1); PG8_BAR;
            PG8_LDA(At, 0, 1); PG8_STAGE(PG8_SA(0, 0), a2, voffA);
            PG8_BAR; PG8_WAIT_L(0); PG8_MMA(1, 0, At, B0); PG8_BAR; PG8_SCHED;
            PG8_STAGE(PG8_SB(0, 1), b2 + hstep, voffB);
            PG8_WAIT_V(6); PG8_BAR; PG8_MMA(1, 1, At, B1); PG8_BAR;
            PG8_LDB(B0, 1, 0); PG8_SCHED; PG8_LDA(At, 1, 0); PG8_STAGE(PG8_SA(0, 1), a2 + hstep, voffA);
            PG8_WAIT_L(8); PG8_BAR; PG8_WAIT_L(0); PG8_MMA(0, 0, At, B0); PG8_BAR; PG8_SCHED;
            PG8_LDB(B1, 1, 1); PG8_STAGE(PG8_SB(1, 0), b3, voffB);
            PG8_BAR; PG8_WAIT_L(0); PG8_MMA(0, 1, At, B1); PG8_BAR;
            PG8_LDA(At, 1, 1); PG8_STAGE(PG8_SA(1, 0), a3, voffA);
            PG8_BAR; PG8_WAIT_L(0); PG8_MMA(1, 0, At, B0); PG8_BAR; PG8_SCHED;
            PG8_STAGE(PG8_SB(1, 1), b3 + hstep, voffB);
            PG8_WAIT_V(6); PG8_BAR; PG8_MMA(1, 1, At, B1); PG8_BAR;
            }
        }
        if constexpr (ALIGN_EPI) { if (wr == 0) PG8_BAR; }
        if constexpr (!Epi::AFTER_DRAIN) { E(acc, cur, wr, wc, fr, fq); S.done(cur); }
        if (!has_next) break;
#pragma unroll
        for (int a = 0; a < 2; ++a)
#pragma unroll
            for (int b = 0; b < 2; ++b)
#pragma unroll
                for (int m = 0; m < 4; ++m)
#pragma unroll
                    for (int n = 0; n < 2; ++n) acc[a][b][m][n] = (f32x4){0.f, 0.f, 0.f, 0.f};
        cur = nxt; cA = nA; cB = nB; ++ui;
        if constexpr (ALIGN_EPI) { if (wr == 1) PG8_BAR; }
    }
    PG8_WAIT_V(0);
    if constexpr (!ALIGN_EPI) { if (wr == 0) PG8_BAR; }
    PG8_BAR;
    if constexpr (Epi::AFTER_DRAIN) { E.fused(acc, cur, wr, wc, fr, fq, lds, wid, lane); S.done(cur); }
#undef PG8_SA
#undef PG8_SB
#undef PG8_STAGE
#undef PG8_LDA
#undef PG8_LDB
#undef PG8_MMA
#undef PG8_WAIT_V
#undef PG8_WAIT_L
#undef PG8_BAR
#undef PG8_SCHED
}
}

namespace att {
#define ATT_LAS __attribute__((address_space(3)))
typedef unsigned short bf16_t;
typedef short bf16x8 __attribute__((ext_vector_type(8)));
typedef short s16x4 __attribute__((ext_vector_type(4)));
typedef float f32x16 __attribute__((ext_vector_type(16)));
typedef float f32x4 __attribute__((ext_vector_type(4)));
typedef unsigned u32x4 __attribute__((ext_vector_type(4)));
typedef float f32x2_t __attribute__((ext_vector_type(2))); typedef __bf16 bf16x2_t __attribute__((ext_vector_type(2)));
constexpr int SEQ = 4096;
constexpr int KP = 144, VP = 320;
constexpr int KB_ = 64 * KP, VB_ = 64 * VP, BUF = KB_ + VB_;
constexpr int A_LDS = 3 * 8192 + 4 * 16384 + 8 * 256 + 8 * 8192;
constexpr int VPB = 192;
constexpr int B_STAGE = 32 * VPB;
constexpr int B_LDS = 8 * B_STAGE + 8 * 256;

__device__ __forceinline__ int crow(int r, int hi) { return (r & 3) + 8 * (r >> 2) + 4 * hi; }
__device__ __forceinline__ unsigned cvtpk(float lo, float hi) { f32x2_t v = {lo, hi}; bf16x2_t b = __builtin_convertvector(v, bf16x2_t); return __builtin_bit_cast(unsigned, b); }
__device__ __forceinline__ bf16x8 pack_p(const f32x16& p, int s) {
    u32x4 w; w.x = cvtpk(p[8 * s], p[8 * s + 1]); w.y = cvtpk(p[8 * s + 2], p[8 * s + 3]); w.z = cvtpk(p[8 * s + 4], p[8 * s + 5]); w.w = cvtpk(p[8 * s + 6], p[8 * s + 7]);
    return __builtin_bit_cast(bf16x8, w); }
typedef short v4i16_t __attribute__((ext_vector_type(4)));
__device__ __forceinline__ s16x4 vtr(const ATT_LAS unsigned char* p) { return __builtin_bit_cast(s16x4, __builtin_amdgcn_ds_read_tr16_b64_v4i16((ATT_LAS v4i16_t*)p)); }
__device__ __forceinline__ bf16x8 vfrag(const ATT_LAS unsigned char* p, int rowstep8) {
    const s16x4 lo = vtr(p), hi = vtr(p + rowstep8);
    return (bf16x8){lo[0], lo[1], lo[2], lo[3], hi[0], hi[1], hi[2], hi[3]}; }
__device__ __forceinline__ float add_x32_(float v) { auto rr = __builtin_amdgcn_permlane32_swap(__float_as_uint(v), __float_as_uint(v), false, false); return __uint_as_float(rr[0]) + __uint_as_float(rr[1]); }
__device__ __forceinline__ float wave_max(float v) {
    v = fmaxf(v, shx<1>(v)); v = fmaxf(v, shx<2>(v)); v = fmaxf(v, shx<4>(v)); v = fmaxf(v, shx<8>(v)); v = fmaxf(v, shx<16>(v));
    return max_x32(v); }
__device__ __forceinline__ float wave_sum(float v) {
    v += shx<1>(v); v += shx<2>(v); v += shx<4>(v); v += shx<8>(v); v += shx<16>(v);
    return add_x32(v); }

struct ATensors {
    const bf16_t* Q; const bf16_t* K; const bf16_t* V; bf16_t* O;
    const float* gain_a;
    const float* lambda_a;
    const float* subln_g;
    float lam_init;
};

template <int NKS, int NVS> struct ALay {
    static constexpr int KST = 8192, VST = 16384;
    static constexpr int K0 = 0, V0 = NKS * KST, SCR = V0 + NVS * VST, O0 = SCR + 8 * 256, END = O0 + 8 * 8192;
};
__device__ __forceinline__ void a_qk_exp(const ATT_LAS unsigned char* ks, const int (&ko)[4], const bf16x8 (&qr)[4], const f32x16& negm, bf16x8 (&pa)[4], float& lsum) {
    bf16x8 a0[4], a1[4];
#pragma unroll
    for (int d0 = 0; d0 < 4; ++d0) { a0[d0] = *(const ATT_LAS bf16x8*)(ks + ko[d0]); a1[d0] = *(const ATT_LAS bf16x8*)(ks + ko[d0] + 32 * 128); }
    f32x16 p0 = __builtin_amdgcn_mfma_f32_32x32x16_bf16(a0[0], qr[0], negm, 0, 0, 0);
    f32x16 p1 = __builtin_amdgcn_mfma_f32_32x32x16_bf16(a1[0], qr[0], negm, 0, 0, 0);
#pragma unroll
    for (int d0 = 1; d0 < 4; ++d0) {
        p0 = __builtin_amdgcn_mfma_f32_32x32x16_bf16(a0[d0], qr[d0], p0, 0, 0, 0);
        p1 = __builtin_amdgcn_mfma_f32_32x32x16_bf16(a1[d0], qr[d0], p1, 0, 0, 0);
    }
    float sa = 0.f, sb = 0.f;
#pragma unroll
    for (int r = 0; r < 16; ++r) { p0[r] = __builtin_amdgcn_exp2f(p0[r]); sa += p0[r]; }
    pa[0] = pack_p(p0, 0); pa[1] = pack_p(p0, 1);
#pragma unroll
    for (int r = 0; r < 16; ++r) { p1[r] = __builtin_amdgcn_exp2f(p1[r]); sb += p1[r]; }
    pa[2] = pack_p(p1, 0); pa[3] = pack_p(p1, 1);
    lsum += sa + sb;
}
__device__ __forceinline__ void a_pv(const ATT_LAS unsigned char* vs, const int (&vo)[4], const bf16x8 (&pa)[4], f32x16 (&o)[4]) {
    bf16x8 vc[4], vn[4];
#pragma unroll
    for (int db = 0; db < 4; ++db) vc[db] = vfrag(vs + vo[db], 8 * 256);
#pragma unroll
    for (int s = 0; s < 4; ++s) {
        if (s < 3) {
#pragma unroll
            for (int db = 0; db < 4; ++db) vn[db] = vfrag(vs + vo[db] + (s + 1) * 16 * 256, 8 * 256);
        }
        __builtin_amdgcn_sched_barrier(0);
#pragma unroll
        for (int db = 0; db < 4; ++db) o[db] = __builtin_amdgcn_mfma_f32_32x32x16_bf16(pa[s], vc[db], o[db], 0, 0, 0);
        __builtin_amdgcn_sched_barrier(0);
#pragma unroll
        for (int db = 0; db < 4; ++db) vc[db] = vn[db];
    }
}
__device__ __forceinline__ void glds16(const void* gsrc, unsigned lds_dst) { unsigned keep;
    asm volatile("s_mov_b32 %0, m0\n\ts_mov_b32 m0, %2\n\ts_nop 0\n\tglobal_load_lds_dwordx4 %1, off\n\ts_mov_b32 m0, %0" : "=&s"(keep) : "v"(gsrc), "s"(lds_dst) : "memory"); }
#define ATT_WAITV(n) asm volatile("s_waitcnt vmcnt(" #n ")" ::: "memory")
template <bool SPLIT>
__device__ __forceinline__ void attn_a_unit(ATT_LAS unsigned char* lds, const ATensors& T, int b, int h, int qb, float negM, float lam, const int wid0) {
    constexpr int NKS = 3, NVS = SPLIT ? 4 : 3; typedef ALay<NKS, NVS> L;
    const int tid_ = wid0 * 64 + fresh_lane();
    const int tid = tid_, lane = tid & 63, r32 = lane & 31, hi = lane >> 5;
    const int wid = wid0;
    const bool late = SPLIT && wid >= 4;
    const size_t rowbase = (size_t)b * SEQ;
    const int q0 = qb * 256 + wid * 32;
    ATT_LAS float* wsf = (ATT_LAS float*)(lds + L::SCR) + wid * 64;
    const int krow_ = wid * 8 + (lane >> 3), kc = (lane & 7) ^ ((krow_ >> 1) & 7);
    const bf16_t* kg = T.K + (rowbase + krow_) * 1024 + h * 128 + kc * 8;
    const int vrow_ = wid * 4 + (lane >> 4), vc_ = (lane & 15) ^ ((vrow_ & 3) << 2);
    const bf16_t* vg = T.V + (rowbase + vrow_) * 1024 + h * 128 + vc_ * 8;
    const unsigned lds0 = (unsigned)(unsigned long)lds;
#define A_DMA(tile, kslot, vslot) do { const int t1_ = (tile) & 63, c1_ = (tile) >> 6; \
        glds16(kg + (size_t)t1_ * 64 * 1024 + c1_ * 64, (unsigned)__builtin_amdgcn_readfirstlane(lds0 + L::K0 + (kslot) * L::KST + wid * 1024)); \
        glds16(vg + (size_t)t1_ * 64 * 1024, (unsigned)__builtin_amdgcn_readfirstlane(lds0 + L::V0 + (vslot) * L::VST + wid * 1024)); \
        glds16(vg + (size_t)t1_ * 64 * 1024 + 32 * 1024, (unsigned)__builtin_amdgcn_readfirstlane(lds0 + L::V0 + (vslot) * L::VST + 8192 + wid * 1024)); } while (0)
    int ko[4], vo[4];
#pragma unroll
    for (int d0 = 0; d0 < 4; ++d0) ko[d0] = r32 * 128 + (((2 * d0 + hi) ^ ((r32 >> 1) & 7)) << 4);
    { const int q = (lane & 15) >> 2, g = (lane >> 4) & 1, p = lane & 3;
#pragma unroll
      for (int db = 0; db < 4; ++db) vo[db] = (4 * hi + q) * 256 + ((((db ^ q) << 2) | (2 * g + (p >> 1))) << 4) + 8 * (p & 1); }
    const bf16_t* qp = T.Q + (rowbase + q0 + r32) * 1024 + h * 128 + hi * 8;
    f32x16 negm;
#pragma unroll
    for (int r = 0; r < 16; ++r) negm[r] = negM;
    A_DMA(0, 0, 0); A_DMA(1, 1, 1);
    ATT_WAITV(3); __builtin_amdgcn_s_barrier();
    f32x16 o[4];
    ATT_LAS unsigned* o0s = (ATT_LAS unsigned*)(lds + L::O0) + wid * 2048 + lane;
    bf16x8 qr[4], pa[4];
    float lsum = 0.f;
    int ks = 0, vs = 0, vsp = 0;
    for (int tt = 0; tt <= 128; ++tt) {
        int ks2 = ks + 2; ks2 = ks2 >= NKS ? ks2 - NKS : ks2; int vs2 = vs + 2; vs2 = vs2 >= NVS ? vs2 - NVS : vs2;
        if (tt + 2 < 128) A_DMA(tt + 2, ks2, vs2);
        if (late && tt > 0) a_pv(lds + L::V0 + vsp * L::VST, vo, pa, o);
        if (tt == 64) {
            const float l = add_x32(lsum);
            if (hi == 0) wsf[r32] = __builtin_amdgcn_rcpf(l);
            asm volatile("s_waitcnt lgkmcnt(0)" ::: "memory");
#pragma unroll
            for (int r = 0; r < 8; ++r) { const float l0 = wsf[crow(2 * r, hi)], l1 = wsf[crow(2 * r + 1, hi)];
#pragma unroll
                for (int db = 0; db < 4; ++db) o0s[(db * 8 + r) * 64] = cvtpk(o[db][2 * r] * l0, o[db][2 * r + 1] * l1); }
            asm volatile("s_waitcnt lgkmcnt(0)" ::: "memory");
        }
        if (tt == 128) {
            const float l = add_x32(lsum);
            if (hi == 0) wsf[r32] = __builtin_amdgcn_rcpf(l);
            asm volatile("s_waitcnt lgkmcnt(0)" ::: "memory");
            const float g0 = T.subln_g[r32], g1 = T.subln_g[32 + r32], g2 = T.subln_g[64 + r32], g3 = T.subln_g[96 + r32];
            const float post = 1.0f - T.lam_init;
#pragma unroll
            for (int r = 0; r < 16; ++r) {
                const float li = wsf[crow(r, hi)] * lam;
                float d[4], sq = 0.f;
#pragma unroll
                for (int db = 0; db < 4; ++db) { const unsigned w = o0s[(db * 8 + (r >> 1)) * 64]; const float a0 = __uint_as_float((r & 1) ? (w & 0xffff0000u) : (w << 16)); d[db] = a0 - o[db][r] * li; sq += d[db] * d[db]; }
                sq += shx<1>(sq); sq += shx<2>(sq); sq += shx<4>(sq); sq += shx<8>(sq); sq += shx<16>(sq);
                const float rn = __builtin_amdgcn_rsqf(sq * (1.0f / 128.0f) + 1e-6f) * post;
                bf16_t* op = T.O + (rowbase + q0 + crow(r, hi)) * 1024 + h * 128 + r32;
                const float v0 = d[0] * rn * g0, v1 = d[1] * rn * g1, v2 = d[2] * rn * g2, v3 = d[3] * rn * g3;
                op[0] = (bf16_t)(cvtpk(v0, v0) & 0xffffu); op[32] = (bf16_t)(cvtpk(v1, v1) & 0xffffu); op[64] = (bf16_t)(cvtpk(v2, v2) & 0xffffu); op[96] = (bf16_t)(cvtpk(v3, v3) & 0xffffu);
            }
            asm volatile("s_waitcnt vmcnt(0) lgkmcnt(0)" ::: "memory");
        }
        if (tt < 128) {
            if ((tt & 63) == 0) {
                const int c = tt >> 6;
#pragma unroll
                for (int d0 = 0; d0 < 4; ++d0) qr[d0] = *(const bf16x8*)(qp + c * 64 + d0 * 16);
                asm volatile("" : "+v"(qr[0]), "+v"(qr[1]), "+v"(qr[2]), "+v"(qr[3]));
#pragma unroll
                for (int db = 0; db < 4; ++db)
#pragma unroll
                    for (int r = 0; r < 16; ++r) o[db][r] = 0.f;
                lsum = 0.f;
            }
            a_qk_exp(lds + L::K0 + ks * L::KST, ko, qr, negm, pa, lsum);
            if (!late) a_pv(lds + L::V0 + vs * L::VST, vo, pa, o);
        }
        if (tt + 2 < 128) ATT_WAITV(3); else ATT_WAITV(0);
        asm volatile("s_waitcnt lgkmcnt(0)" ::: "memory");
        __builtin_amdgcn_s_barrier();
        vsp = vs; ks = ks + 1 >= NKS ? 0 : ks + 1; vs = vs + 1 >= NVS ? 0 : vs + 1;
    }
#undef A_DMA
}

struct A2Lay { static constexpr int KST = 16384, VST = 16384, K0 = 0, V0 = 2 * KST, Q0 = V0 + 2 * VST, SCR = Q0 + 8 * 8192, END = SCR + 8 * 256; };
__device__ __forceinline__ void a2_qk_half(const ATT_LAS unsigned char* ks, const ATT_LAS unsigned char* qs, const int (&ko)[4], bf16x8& pa_lo, bf16x8& pa_hi, float& lsum) {
    const f32x16 zero = {0.f, 0.f, 0.f, 0.f, 0.f, 0.f, 0.f, 0.f, 0.f, 0.f, 0.f, 0.f, 0.f, 0.f, 0.f, 0.f};
    bf16x8 q[4], k[4];
#pragma unroll
    for (int d0 = 0; d0 < 4; ++d0) { q[d0] = *(const ATT_LAS bf16x8*)(qs + ko[d0]); k[d0] = *(const ATT_LAS bf16x8*)(ks + ko[d0]); }
    f32x16 p = __builtin_amdgcn_mfma_f32_32x32x16_bf16(k[0], q[0], zero, 0, 0, 0);
#pragma unroll
    for (int d0 = 1; d0 < 4; ++d0) p = __builtin_amdgcn_mfma_f32_32x32x16_bf16(k[d0], q[d0], p, 0, 0, 0);
    float sa = 0.f, sb = 0.f;
#pragma unroll
    for (int r = 0; r < 16; r += 2) { p[r] = __builtin_amdgcn_exp2f(p[r]); p[r + 1] = __builtin_amdgcn_exp2f(p[r + 1]); sa += p[r]; sb += p[r + 1]; }
    pa_lo = pack_p(p, 0); pa_hi = pack_p(p, 1);
    lsum += sa + sb;
    __builtin_amdgcn_sched_barrier(0);
}
#define A2_EXP4(P, g, sa, sb) do { P[4 * (g)] = __builtin_amdgcn_exp2f(P[4 * (g)]); P[4 * (g) + 1] = __builtin_amdgcn_exp2f(P[4 * (g) + 1]); P[4 * (g) + 2] = __builtin_amdgcn_exp2f(P[4 * (g) + 2]); \
        P[4 * (g) + 3] = __builtin_amdgcn_exp2f(P[4 * (g) + 3]); sa += P[4 * (g)] + P[4 * (g) + 2]; sb += P[4 * (g) + 1] + P[4 * (g) + 3]; } while (0)
#define A2_LD1(kk, qq, kb_, qb_, d0) do { kk = *(const ATT_LAS bf16x8*)((kb_) + ko[d0]); qq = *(const ATT_LAS bf16x8*)((qb_) + ko[d0]); } while (0)
__device__ __forceinline__ void a2_qk_pair(const ATT_LAS unsigned char* k0b, const ATT_LAS unsigned char* k1b, const ATT_LAS unsigned char* q0b, const ATT_LAS unsigned char* q1b, const int (&ko)[4],
                                           bf16x8& pm0a, bf16x8& pm0b, bf16x8& pm1a, bf16x8& pm1b, float& ls0, float& ls1) {
    const f32x16 zero = {0.f, 0.f, 0.f, 0.f, 0.f, 0.f, 0.f, 0.f, 0.f, 0.f, 0.f, 0.f, 0.f, 0.f, 0.f, 0.f};
    bf16x8 ka, qa, kb, qb2; f32x16 pA, pB; float sa = 0.f, sb = 0.f;
    A2_LD1(ka, qa, k0b, q0b, 0); A2_LD1(kb, qb2, k0b, q0b, 1);
    pA = __builtin_amdgcn_mfma_f32_32x32x16_bf16(ka, qa, zero, 0, 0, 0);
    __builtin_amdgcn_sched_barrier(0);
    A2_LD1(ka, qa, k0b, q0b, 2);
    pA = __builtin_amdgcn_mfma_f32_32x32x16_bf16(kb, qb2, pA, 0, 0, 0);
    __builtin_amdgcn_sched_barrier(0);
    A2_LD1(kb, qb2, k0b, q0b, 3);
    pA = __builtin_amdgcn_mfma_f32_32x32x16_bf16(ka, qa, pA, 0, 0, 0);
    __builtin_amdgcn_sched_barrier(0);
    A2_LD1(ka, qa, k1b, q1b, 0);
    pA = __builtin_amdgcn_mfma_f32_32x32x16_bf16(kb, qb2, pA, 0, 0, 0);
    __builtin_amdgcn_sched_barrier(0);
    A2_LD1(kb, qb2, k1b, q1b, 1);
    __builtin_amdgcn_sched_barrier(0);
    pB = __builtin_amdgcn_mfma_f32_32x32x16_bf16(ka, qa, zero, 0, 0, 0); A2_EXP4(pA, 0, sa, sb); __builtin_amdgcn_sched_barrier(0);
    A2_LD1(ka, qa, k1b, q1b, 2); __builtin_amdgcn_sched_barrier(0);
    pB = __builtin_amdgcn_mfma_f32_32x32x16_bf16(kb, qb2, pB, 0, 0, 0); A2_EXP4(pA, 1, sa, sb); __builtin_amdgcn_sched_barrier(0);
    A2_LD1(kb, qb2, k1b, q1b, 3); __builtin_amdgcn_sched_barrier(0);
    pB = __builtin_amdgcn_mfma_f32_32x32x16_bf16(ka, qa, pB, 0, 0, 0); A2_EXP4(pA, 2, sa, sb); __builtin_amdgcn_sched_barrier(0);
    pB = __builtin_amdgcn_mfma_f32_32x32x16_bf16(kb, qb2, pB, 0, 0, 0); A2_EXP4(pA, 3, sa, sb); __builtin_amdgcn_sched_barrier(0);
    pm0a = pack_p(pA, 0); pm0b = pack_p(pA, 1);
    ls0 += sa + sb; sa = 0.f; sb = 0.f;
#pragma unroll
    for (int g = 0; g < 4; ++g) A2_EXP4(pB, g, sa, sb);
    pm1a = pack_p(pB, 0); pm1b = pack_p(pB, 1);
    ls1 += sa + sb;
    __builtin_amdgcn_sched_barrier(0);
}
#define A2_PV2(s0_, p0a, p0b, p1a, p1b) do { \
        bf16x8 vc[4], vn[4]; \
        _Pragma("unroll") for (int db = 0; db < 4; ++db) vc[db] = vfrag(vs + vo[db] + (s0_) * 16 * 256, 8 * 256); \
        _Pragma("unroll") for (int db = 0; db < 4; ++db) vn[db] = vfrag(vs + vo[db] + ((s0_) + 1) * 16 * 256, 8 * 256); \
        __builtin_amdgcn_sched_barrier(0); \
        _Pragma("unroll") for (int db = 0; db < 4; ++db) { o0[db] = __builtin_amdgcn_mfma_f32_32x32x16_bf16(p0a, vc[db], o0[db], 0, 0, 0); o1[db] = __builtin_amdgcn_mfma_f32_32x32x16_bf16(p1a, vc[db], o1[db], 0, 0, 0); } \
        __builtin_amdgcn_sched_barrier(0); \
        _Pragma("unroll") for (int db = 0; db < 4; ++db) { o0[db] = __builtin_amdgcn_mfma_f32_32x32x16_bf16(p0b, vn[db], o0[db], 0, 0, 0); o1[db] = __builtin_amdgcn_mfma_f32_32x32x16_bf16(p1b, vn[db], o1[db], 0, 0, 0); } \
        __builtin_amdgcn_sched_barrier(0); } while (0)
__device__ __forceinline__ void attn_a_unit2(ATT_LAS unsigned char* lds, const ATensors& T, int b, int h, int qb, float lam, const int wid0) {
    typedef A2Lay L;
    const int lane = fresh_lane(), r32 = lane & 31, hi = lane >> 5, wid = wid0;
    const size_t rowbase = (size_t)b * SEQ;
    const int q0 = qb * 256 + wid * 32;
    const int krow_ = wid * 8 + (lane >> 3), kc = (lane & 7) ^ ((krow_ >> 1) & 7);
    const unsigned koff = (unsigned)((rowbase + krow_) * 1024 + h * 128 + kc * 8);
    const int vrow_ = wid * 4 + (lane >> 4), vc_ = (lane & 15) ^ ((vrow_ & 3) << 2);
    const unsigned voff = (unsigned)((rowbase + vrow_) * 1024 + h * 128 + vc_ * 8);
    const unsigned lds0 = (unsigned)(unsigned long)lds;
#define A2_DMA(tile, slot) do { \
        glds16(T.K + (size_t)(koff + (unsigned)(tile) * 65536u), (unsigned)__builtin_amdgcn_readfirstlane(lds0 + L::K0 + (slot) * L::KST + wid * 1024)); \
        glds16(T.K + (size_t)(koff + (unsigned)(tile) * 65536u + 64u), (unsigned)__builtin_amdgcn_readfirstlane(lds0 + L::K0 + (slot) * L::KST + 8192 + wid * 1024)); \
        glds16(T.V + (size_t)(voff + (unsigned)(tile) * 65536u), (unsigned)__builtin_amdgcn_readfirstlane(lds0 + L::V0 + (slot) * L::VST + wid * 1024)); \
        glds16(T.V + (size_t)(voff + (unsigned)(tile) * 65536u + 32768u), (unsigned)__builtin_amdgcn_readfirstlane(lds0 + L::V0 + (slot) * L::VST + 8192 + wid * 1024)); } while (0)
#pragma unroll
    for (int i = 0; i < 8; ++i) { const int c = i >> 2, m = (i & 3) * 64 + lane, row = m >> 3, gch = (m & 7) ^ ((row >> 1) & 7);
        glds16(T.Q + (rowbase + q0 + row) * 1024 + h * 128 + c * 64 + gch * 8, (unsigned)__builtin_amdgcn_readfirstlane(lds0 + L::Q0 + wid * 8192 + i * 1024)); }
    A2_DMA(0, 0);
    f32x16 o0[4], o1[4];
#pragma unroll
    for (int db = 0; db < 4; ++db)
#pragma unroll
        for (int r = 0; r < 16; ++r) { o0[db][r] = 0.f; o1[db][r] = 0.f; }
    float ls0 = 0.f, ls1 = 0.f;
    ATT_WAITV(0); __builtin_amdgcn_s_barrier();
    const ATT_LAS unsigned char* qbase = lds + L::Q0 + wid * 8192;
    for (int t = 0; t < 64; ++t) {
        const int slot = t & 1;
        if (t + 1 < 64) A2_DMA(t + 1, slot ^ 1);
        {
            const ATT_LAS unsigned char* k0 = lds + L::K0 + slot * L::KST;
            const ATT_LAS unsigned char* vs = lds + L::V0 + slot * L::VST;
            int vo[4];
            { const int ln2 = fresh_lane(), q = (ln2 & 15) >> 2, g = (ln2 >> 4) & 1, p = ln2 & 3, h2 = ln2 >> 5;
#pragma unroll
              for (int db = 0; db < 4; ++db) vo[db] = (4 * h2 + q) * 256 + ((((db ^ q) << 2) | (2 * g + (p >> 1))) << 4) + 8 * (p & 1); }
            int ko[4];
            { const int ln3 = fresh_lane(), r3 = ln3 & 31, h3 = ln3 >> 5;
#pragma unroll
              for (int d0 = 0; d0 < 4; ++d0) ko[d0] = r3 * 128 + (((2 * d0 + h3) ^ ((r3 >> 1) & 7)) << 4); }
            bf16x8 p0a, p0b, p1a, p1b;
            a2_qk_pair(k0, k0 + 8192, qbase, qbase + 4096, ko, p0a, p0b, p1a, p1b, ls0, ls1);
            A2_PV2(0, p0a, p0b, p1a, p1b);
            a2_qk_pair(k0 + 32 * 128, k0 + 8192 + 32 * 128, qbase, qbase + 4096, ko, p0a, p0b, p1a, p1b, ls0, ls1);
            A2_PV2(2, p0a, p0b, p1a, p1b);
        }
        ATT_WAITV(0);
        asm volatile("s_waitcnt lgkmcnt(0)" ::: "memory");
        __builtin_amdgcn_s_barrier();
    }
#undef A2_DMA
    {
        const int ln = fresh_lane(), r32f = ln & 31, hif = ln >> 5;
        ATT_LAS float* wsf2 = (ATT_LAS float*)(lds + L::SCR) + wid * 64;
        const float l0 = add_x32_(ls0), l1 = add_x32_(ls1);
        if (hif == 0) { wsf2[r32f] = __builtin_amdgcn_rcpf(l0); wsf2[32 + r32f] = __builtin_amdgcn_rcpf(l1) * lam; }
        asm volatile("s_waitcnt lgkmcnt(0)" ::: "memory");
        const float g0 = T.subln_g[r32f], g1 = T.subln_g[32 + r32f], g2 = T.subln_g[64 + r32f], g3 = T.subln_g[96 + r32f];
        float lin = T.lam_init; asm volatile("" : "+v"(lin));
        const float post = 1.0f - lin;
#pragma unroll
        for (int r = 0; r < 16; ++r) {
            const float li0 = wsf2[crow(r, hif)], li1 = wsf2[32 + crow(r, hif)];
            float d[4], sq = 0.f;
#pragma unroll
            for (int db = 0; db < 4; ++db) { d[db] = o0[db][r] * li0 - o1[db][r] * li1; sq += d[db] * d[db]; }
            sq += shx<1>(sq); sq += shx<2>(sq); sq += shx<4>(sq); sq += shx<8>(sq); sq += shx<16>(sq);
            const float rn = __builtin_amdgcn_rsqf(sq * (1.0f / 128.0f) + 1e-6f) * post;
            ATT_LAS bf16_t* op = (ATT_LAS bf16_t*)(lds + L::Q0 + wid * 8192 + crow(r, hif) * 256) + r32f;
            const float v0 = d[0] * rn * g0, v1 = d[1] * rn * g1, v2 = d[2] * rn * g2, v3 = d[3] * rn * g3;
            op[0] = (bf16_t)(cvtpk(v0, v0) & 0xffffu); op[32] = (bf16_t)(cvtpk(v1, v1) & 0xffffu); op[64] = (bf16_t)(cvtpk(v2, v2) & 0xffffu); op[96] = (bf16_t)(cvtpk(v3, v3) & 0xffffu);
        }
        asm volatile("s_waitcnt lgkmcnt(0)" ::: "memory");
#pragma unroll
        for (int it = 0; it < 8; ++it) { const int c = it * 64 + ln, row = c >> 4, ch = c & 15;
            const u32x4 w = *(const ATT_LAS u32x4*)(lds + L::Q0 + wid * 8192 + row * 256 + ch * 16);
            *(u32x4*)(T.O + (rowbase + q0 + row) * 1024 + h * 128 + ch * 8) = w; }
        asm volatile("s_waitcnt vmcnt(0) lgkmcnt(0)" ::: "memory");
        __builtin_amdgcn_s_barrier();
    }
}

struct BTensors {
    const bf16_t* Q; const bf16_t* K; const bf16_t* V;
    bf16_t* O;
};
constexpr int B_ACC = 8 * B_STAGE + 8 * 256;
constexpr int B_LACC = B_ACC + 512 * 64 * 2;
constexpr int B_LDS2 = B_LACC + 512 * 4;
__device__ __forceinline__ void b_load(const BTensors& T, size_t rowbase, int j, int g, int lg, int rg, int p0, int lane, bf16x8 (&kf)[4], u32x4 (&vr)[4]) {
    const int r32 = lane & 31, hi = lane >> 5, L = SEQ >> lg;
    int pk = p0 + r32; pk = pk < 0 ? 0 : (pk >= L ? L - 1 : pk);
    const bf16_t* kp = T.K + (rowbase + ((size_t)pk << lg) + rg) * 768 + g * 256 + j * 64 + hi * 8;
#pragma unroll
    for (int d0 = 0; d0 < 4; ++d0) kf[d0] = *(const bf16x8*)(kp + d0 * 16);
#pragma unroll
    for (int it = 0; it < 4; ++it) { const int idx = it * 64 + lane, row = idx >> 3, chk = idx & 7;
        int pv = p0 + row; pv = pv < 0 ? 0 : (pv >= L ? L - 1 : pv);
        vr[it] = *(const u32x4*)(T.V + (rowbase + ((size_t)pv << lg) + rg) * 768 + g * 256 + j * 64 + chk * 8); }
}
__device__ __forceinline__ void attn_b_block(ATT_LAS unsigned char* lds, const BTensors& T, int b, int j, int blk, const int wid0) {
    const int lane = fresh_lane(), r32 = lane & 31, hi = lane >> 5, wid = wid0;
    ATT_LAS unsigned char* stage = lds + wid * B_STAGE;
    ATT_LAS float* wsf = (ATT_LAS float*)(lds + 8 * B_STAGE) + wid * 64;
    ATT_LAS unsigned short* acc = (ATT_LAS unsigned short*)(lds + B_ACC);
    ATT_LAS float* lacc = (ATT_LAS float*)(lds + B_LACC);
    const size_t rowbase = (size_t)b * SEQ;
    const int vfo = (4 * hi + ((lane & 15) >> 2)) * VPB + (((lane >> 4) & 1) * 16 + (lane & 3) * 4) * 2;
    const f32x16 zero = {0.f, 0.f, 0.f, 0.f, 0.f, 0.f, 0.f, 0.f, 0.f, 0.f, 0.f, 0.f, 0.f, 0.f, 0.f, 0.f};
    for (int g = 0; g < 3; ++g) {
        const int lg = 2 * g, dil = 1 << lg, L = SEQ >> lg;
        for (int rd = 0; rd < 2; ++rd) {
            const int item = wid + 8 * rd, rg = item & (dil - 1), bb = item >> lg;
            const int pbase = ((blk * 512) >> lg) + 32 * bb;
            const int pq = pbase + r32;
            const int tl0 = rg + ((32 * bb) << lg);
            bf16x8 qr[4], kf[4], kn[4]; u32x4 vr[4], vn[4];
            { const bf16_t* qp = T.Q + (rowbase + blk * 512 + tl0 + (r32 << lg)) * 768 + g * 256 + j * 64 + hi * 8;
#pragma unroll
              for (int d0 = 0; d0 < 4; ++d0) qr[d0] = *(const bf16x8*)(qp + d0 * 16); }
            f32x16 o[2] = {zero, zero};
            float lsum = 0.f;
            b_load(T, rowbase, j, g, lg, rg, pbase - 64, lane, kf, vr);
#pragma unroll
            for (int ch = 0; ch < 5; ++ch) {
                const int p0 = pbase - 64 + 32 * ch;
                if (ch + 1 < 5) b_load(T, rowbase, j, g, lg, rg, p0 + 32, lane, kn, vn);
                asm volatile("s_waitcnt lgkmcnt(0)" ::: "memory");
#pragma unroll
                for (int it = 0; it < 4; ++it) { const int i2 = it * 64 + lane, row = i2 >> 3, chk = i2 & 7;
                    *(ATT_LAS u32x4*)(stage + row * VPB + chk * 16) = vr[it]; }
                f32x16 p = __builtin_amdgcn_mfma_f32_32x32x16_bf16(kf[0], qr[0], zero, 0, 0, 0);
#pragma unroll
                for (int d0 = 1; d0 < 4; ++d0) p = __builtin_amdgcn_mfma_f32_32x32x16_bf16(kf[d0], qr[d0], p, 0, 0, 0);
                float sacc = 0.f;
                const bool full = (ch >= 1 && ch <= 3) && (p0 >= 0) && (p0 + 31 < L);
                if (full) {
#pragma unroll
                    for (int x = 0; x < 16; ++x) { p[x] = __builtin_amdgcn_exp2f(p[x]); sacc += p[x]; }
                } else {
                    const int lo = max(pq - 64, 0) - (p0 + 4 * hi), span = min(pq + 64, L - 1) - (p0 + 4 * hi) - lo;
#pragma unroll
                    for (int x = 0; x < 16; ++x) {
                        const int cx = (x & 3) + 8 * (x >> 2);
                        const bool ok = (unsigned)(cx - lo) <= (unsigned)span;
                        const float e = __builtin_amdgcn_exp2f(p[x]);
                        p[x] = ok ? e : 0.f; sacc += p[x];
                    }
                }
                lsum += sacc;
                asm volatile("s_waitcnt lgkmcnt(0)" ::: "memory");
#pragma unroll
                for (int s2 = 0; s2 < 2; ++s2) {
                    const bf16x8 pa = pack_p(p, s2);
#pragma unroll
                    for (int db = 0; db < 2; ++db) {
                        const bf16x8 vf = vfrag(stage + vfo + s2 * 16 * VPB + db * 64, 8 * VPB);
                        o[db] = __builtin_amdgcn_mfma_f32_32x32x16_bf16(pa, vf, o[db], 0, 0, 0);
                    }
                }
#pragma unroll
                for (int d0 = 0; d0 < 4; ++d0) { kf[d0] = kn[d0]; vr[d0] = vn[d0]; }
            }
            const float l = add_x32_(lsum);
            if (g == 0) {
                if (hi == 0) lacc[tl0 + (r32 << lg)] = l;
#pragma unroll
                for (int x = 0; x < 16; ++x) { const int tl = tl0 + (crow(x, hi) << lg);
                    acc[tl * 64 + r32] = (unsigned short)(cvtpk(o[0][x], o[0][x]) & 0xffffu); acc[tl * 64 + 32 + r32] = (unsigned short)(cvtpk(o[1][x], o[1][x]) & 0xffffu); }
            } else if (g == 1) {
                if (hi == 0) lacc[tl0 + (r32 << lg)] += l;
#pragma unroll
                for (int x = 0; x < 16; ++x) { const int tl = tl0 + (crow(x, hi) << lg);
                    const float a0 = __uint_as_float((unsigned)acc[tl * 64 + r32] << 16) + o[0][x], a1 = __uint_as_float((unsigned)acc[tl * 64 + 32 + r32] << 16) + o[1][x];
                    acc[tl * 64 + r32] = (unsigned short)(cvtpk(a0, a0) & 0xffffu); acc[tl * 64 + 32 + r32] = (unsigned short)(cvtpk(a1, a1) & 0xffffu); }
            } else {
                if (hi == 0) wsf[r32] = l + lacc[tl0 + (r32 << lg)];
                asm volatile("s_waitcnt lgkmcnt(0)" ::: "memory");
#pragma unroll
                for (int x = 0; x < 16; ++x) { const int tl = tl0 + (crow(x, hi) << lg);
                    const float li = __builtin_amdgcn_rcpf(wsf[crow(x, hi)]);
                    const float a0 = (__uint_as_float((unsigned)acc[tl * 64 + r32] << 16) + o[0][x]) * li, a1 = (__uint_as_float((unsigned)acc[tl * 64 + 32 + r32] << 16) + o[1][x]) * li;
                    bf16_t* op = T.O + (rowbase + blk * 512 + tl) * 256 + j * 64 + r32;
                    op[0] = (bf16_t)(cvtpk(a0, a0) & 0xffffu); op[32] = (bf16_t)(cvtpk(a1, a1) & 0xffffu); }
                asm volatile("s_waitcnt lgkmcnt(0)" ::: "memory");
            }
        }
        __syncthreads();
    }
}
}

namespace cg = cooperative_groups;
#define LAS __attribute__((address_space(3)))
typedef unsigned short bf16;
typedef float f32x4 __attribute__((ext_vector_type(4)));
typedef unsigned v4u __attribute__((ext_vector_type(4)));
constexpr int NWAVES = 8, NTHREADS = 512;
constexpr int BATCH = 8, SEQ = 4096, D = 1024, T = BATCH * SEQ, FF = 4096, DEPTH = 2;
constexpr int IN_COLS = 7424, QKV_COLS = 5376;
constexpr size_t MiB = 1u << 20;
constexpr size_t WS_ROWSS = 1 * MiB;
constexpr size_t WS_MOD = WS_ROWSS + 4 * (size_t)T * 4;
constexpr size_t WS_SBIN = WS_MOD + 2 * 8 * 6144 * 4;
constexpr size_t WS_SBUP = WS_SBIN + 2 * 8 * 7424 * 4;
constexpr size_t WS_COS = 3 * MiB, WS_SIN = 4 * MiB;
constexpr size_t WS_WT = 6 * MiB;
constexpr size_t WT_IN = 0, WT_A = WT_IN + (size_t)IN_COLS * D, WT_B = WT_A + (size_t)D * D, WT_OUT = WT_B + (size_t)D * 256, WT_UP = WT_OUT + (size_t)D * D, WT_DN = WT_UP + (size_t)FF * D, WT_LAYER = WT_DN + (size_t)D * FF;
constexpr size_t WS_QA = 76 * MiB, WS_KA = 140 * MiB, WS_VA = 204 * MiB, WS_QB = 268 * MiB, WS_KB = 316 * MiB, WS_VB = 364 * MiB, WS_XS = 412 * MiB, WS_OB = 476 * MiB, WS_END = 492 * MiB;
constexpr size_t WS_TMP1 = 140 * MiB, WS_GA = 268 * MiB, WS_U = 332 * MiB, WS_H = 76 * MiB;
static_assert(WS_WT + 2 * WT_LAYER * 2 <= WS_QA, "weights fit");
static_assert(WS_SBUP + 2 * 8 * 4096 * 4 <= WS_COS, "small fits");
#ifndef ATT_SPLIT
#define ATT_SPLIT true
#endif
constexpr int LDS_BYTES = 163840;
static_assert(att::A_LDS <= LDS_BYTES && att::B_LDS2 <= LDS_BYTES && att::A2Lay::END <= LDS_BYTES - 64, "LDS");

#define XB_TMO      128
#define XB_XCNT(j)  (256  + 64 * (j))
#define XB_XSUB(j)  (1280 + 64 * (j))
#define XB_XGEN(j)  (2304 + 64 * (j))
#define XB_TOP      3328
#define XB_TOPGEN   3392
#define XCD_BAR_WORDS 3456
#define XB_SPIN_CAP (1u << 18)

__device__ __forceinline__ unsigned xb_ld(unsigned* p)              { return __hip_atomic_load(p, __ATOMIC_RELAXED, __HIP_MEMORY_SCOPE_AGENT); }
__device__ __forceinline__ unsigned xb_add(unsigned* p, unsigned v) { return __hip_atomic_fetch_add(p, v, __ATOMIC_RELAXED, __HIP_MEMORY_SCOPE_AGENT); }
__device__ __forceinline__ unsigned xb_xcc_id() { return (unsigned)__builtin_amdgcn_s_getreg((3 << 11) | 20) & 0xFu; }
#define XB_SPIN(cond, bar) do { unsigned _sp = 0; while (cond) { __builtin_amdgcn_s_sleep(1); \
    if ((++_sp & 255u) == 0u) { if (xb_ld(&(bar)[XB_TMO])) break; if (_sp > XB_SPIN_CAP) { atomicAdd(&(bar)[XB_TMO], 1u); break; } } } } while (0)

struct XcdBarrier {
    unsigned* bar; unsigned x;
    volatile __attribute__((address_space(3))) unsigned* st;
};

__device__ __forceinline__ XcdBarrier xcd_barrier_post(unsigned* bar, volatile __attribute__((address_space(3))) unsigned* st, bool leader) {
    XcdBarrier b; b.bar = bar; b.x = xb_xcc_id(); b.st = st;
    if (leader) (void)xb_add(&bar[XB_XCNT(b.x)], 1u);
    return b;
}
__device__ __forceinline__ void xcd_barrier_complete(unsigned* bar, unsigned x, unsigned& nloc, unsigned& nx) {
    const unsigned G = gridDim.x * gridDim.y * gridDim.z;
    unsigned sum, cnt, mine, sp = 0u;
    for (;;) {
        sum = 0u; cnt = 0u; mine = 0u;
#pragma unroll
        for (unsigned j = 0; j < 16; ++j) { const unsigned c = xb_ld(&bar[XB_XCNT(j)]); sum += c; cnt += (c > 0u) ? 1u : 0u; mine = (j == x) ? c : mine; }
        if (sum == G) break;
        __builtin_amdgcn_s_sleep(1);
        if ((++sp & 255u) == 0u) { if (xb_ld(&bar[XB_TMO])) break; if (sp > XB_SPIN_CAP) { atomicAdd(&bar[XB_TMO], 1u); break; } }
    }
    nloc = mine > 0u ? mine : 1u; nx = cnt > 0u ? cnt : 1u;
}

__device__ __forceinline__ void xcd_barrier(const XcdBarrier& b, bool leader) {
    asm volatile("s_waitcnt vmcnt(0)" ::: "memory");
    __syncthreads();
    if (leader) {
        unsigned* bar = b.bar; unsigned myx = b.x; asm volatile("" : "+s"(bar), "+s"(myx));
        __builtin_amdgcn_s_waitcnt(0);
        unsigned nloc = b.st[0], nx = b.st[1];
        if (nloc == 0u) { xcd_barrier_complete(bar, myx, nloc, nx); b.st[0] = nloc; b.st[1] = nx; }
        const unsigned old = xb_add(&bar[XB_XSUB(myx)], 1u);
        const unsigned gen = old / nloc;
        if (old + 1u == (gen + 1u) * nloc) {
            __builtin_amdgcn_fence(__ATOMIC_RELEASE, "agent");
            asm volatile("s_waitcnt vmcnt(0)" ::: "memory");
            const unsigned og = xb_add(&bar[XB_TOP], 1u);
            const unsigned tg = og / nx;
            if (og + 1u == (tg + 1u) * nx) xb_add(&bar[XB_TOPGEN], 1u);
            else XB_SPIN(xb_ld(&bar[XB_TOPGEN]) == tg, bar);
            __builtin_amdgcn_fence(__ATOMIC_ACQUIRE, "agent");
            xb_add(&bar[XB_XGEN(myx)], 1u);
            asm volatile("s_waitcnt vmcnt(0)" ::: "memory");
        } else {
            XB_SPIN(xb_ld(&bar[XB_XGEN(myx)]) == gen, bar);
            __builtin_amdgcn_fence(__ATOMIC_ACQUIRE, "agent");
            asm volatile("s_waitcnt vmcnt(0)" ::: "memory");
        }
    }
    __syncthreads();
}

struct Args {
    const float *x, *c; const int* pos;
    const float *ada_w, *ada_b, *norm_mix_g, *norm_mlp_g, *w_in, *qk_gain_a, *lambda_a, *subln_g_a, *qk_gain_b, *w_branch_a, *w_branch_b, *gate_bias, *w_out, *w_mlp_up, *w_mlp_down;
    float* out; unsigned char* ws;
};

__device__ __forceinline__ unsigned f2bf(float f) { unsigned u = __builtin_bit_cast(unsigned, f); return (u + 0x7fffu + ((u >> 16) & 1u)) >> 16; }
__device__ __forceinline__ unsigned pk2(float lo, float hi) { return f2bf(lo) | (f2bf(hi) << 16); }

__device__ __forceinline__ void conv_item(const float* W, int K, int N, bf16* WT, int perm_limit, LAS float* scr, int item, const int wid0) {
    const int tid = wid0 * 64 + fresh_lane(); const int nblk = N / 64, kb = item / nblk, nb = item % nblk, k0 = 256 * kb, n0 = 64 * nb;
    float r[32];
#pragma unroll
    for (int i = 0; i < 32; ++i) { const int kk = i * 8 + (tid >> 6), nn = tid & 63; r[i] = W[(size_t)(k0 + kk) * N + n0 + nn]; }
#pragma unroll
    for (int i = 0; i < 32; ++i) { const int kk = i * 8 + (tid >> 6), nn = tid & 63; scr[kk * 65 + nn] = r[i]; }
    __syncthreads();
    { const int n = tid >> 3, c = tid & 7;
      int col = n0 + n;
      if (col < perm_limit) { const int tile = col >> 8, nl = col & 255, wc = nl >> 6, bj = (nl >> 5) & 1, j = nl & 31; col = tile * 256 + 128 * bj + 32 * wc + j; }
#pragma unroll
      for (int hk = 0; hk < 4; ++hk) { const LAS float* s = scr + (64 * hk + 8 * c) * 65 + n;
          v4u o; o.x = pk2(s[0], s[65]); o.y = pk2(s[2 * 65], s[3 * 65]); o.z = pk2(s[4 * 65], s[5 * 65]); o.w = pk2(s[6 * 65], s[7 * 65]);
          *(v4u*)(WT + (size_t)col * K + k0 + 64 * hk + 8 * c) = o; } }
    __syncthreads();
}
__device__ __forceinline__ void gemv8_item(const float* W, int N, const float* bias, float* out, int ldo, int n0, const LAS float* in_s, LAS float* red, const int wid0) {
    const int lane = fresh_lane(), wid = wid0, tid = wid0 * 64 + lane;
    float a0[8], a1[8];
#pragma unroll
    for (int b = 0; b < 8; ++b) { a0[b] = 0.f; a1[b] = 0.f; }
    const float* wp = W + (size_t)(128 * wid) * N + n0 + 2 * lane;
#pragma unroll 32
    for (int k = 0; k < 128; ++k) {
        const float2 w = *(const float2*)(wp + (size_t)k * N);
        const f32x4 i0 = *(const LAS f32x4*)(in_s + (128 * wid + k) * 8), i1 = *(const LAS f32x4*)(in_s + (128 * wid + k) * 8 + 4);
#pragma unroll
        for (int b = 0; b < 4; ++b) { a0[b] += i0[b] * w.x; a1[b] += i0[b] * w.y; a0[4 + b] += i1[b] * w.x; a1[4 + b] += i1[b] * w.y; }
    }
#pragma unroll
    for (int b = 0; b < 8; ++b) { red[(wid * 8 + b) * 128 + 2 * lane] = a0[b]; red[(wid * 8 + b) * 128 + 2 * lane + 1] = a1[b]; }
    __syncthreads();
#pragma unroll
    for (int i = 0; i < 2; ++i) { const int o = tid + i * 512, b = o >> 7, c = o & 127; float s = bias ? bias[n0 + c] : 0.f;
#pragma unroll
        for (int w = 0; w < 8; ++w) s += red[(w * 8 + b) * 128 + c];
        out[(size_t)b * ldo + n0 + c] = s; }
    __syncthreads();
}

__global__ void __launch_bounds__(NTHREADS, 2) fwd_megakernel(Args a) {
    extern __shared__ __attribute__((aligned(16))) unsigned char lds_raw[];
    LAS unsigned char* lds = (LAS unsigned char*)lds_raw;
    cg::grid_group grid = cg::this_grid();
    const int wid0 = __builtin_amdgcn_readfirstlane(threadIdx.x >> 6);
#define FRESH_IDS() const int lane = fresh_lane(), wid = wid0, tid = wid0 * 64 + lane; (void)lane; (void)wid; (void)tid
    const int G = gridDim.x, bx = blockIdx.x;
    unsigned char* ws = a.ws;
    volatile LAS unsigned* bar_st = (volatile LAS unsigned*)(lds + LDS_BYTES - 64);
    { const bool ld0 = (wid0 == 0) && (fresh_lane() == 0); if (ld0) { bar_st[0] = 0u; bar_st[1] = 0u; } __syncthreads(); }
    XcdBarrier xbar = xcd_barrier_post((unsigned*)ws, bar_st, (wid0 == 0) && (fresh_lane() == 0));
    if ((wid0 == 0) && (fresh_lane() == 0)) bar_st[2] = atomicAdd((unsigned*)ws + 3584 + 64 * xbar.x, 1u);
#define GRID_BAR() xcd_barrier(xbar, (wid0 == 0) && (fresh_lane() == 0))
    float* rowss = (float*)(ws + WS_ROWSS); float* mod = (float*)(ws + WS_MOD); float* sbin = (float*)(ws + WS_SBIN); float* sbup = (float*)(ws + WS_SBUP);
    float* cosT = (float*)(ws + WS_COS); float* sinT = (float*)(ws + WS_SIN);
    bf16* WT = (bf16*)(ws + WS_WT);
    bf16 *QA = (bf16*)(ws + WS_QA), *KA = (bf16*)(ws + WS_KA), *VA = (bf16*)(ws + WS_VA), *QB = (bf16*)(ws + WS_QB), *KB = (bf16*)(ws + WS_KB), *VB = (bf16*)(ws + WS_VB);
    bf16 *XS = (bf16*)(ws + WS_XS), *OB = (bf16*)(ws + WS_OB), *GA = (bf16*)(ws + WS_GA), *U = (bf16*)(ws + WS_U), *H = (bf16*)(ws + WS_H);
    bf16* TMP1 = (bf16*)(ws + WS_TMP1);

    {
        FRESH_IDS();
        LAS float* scr = (LAS float*)lds;
        constexpr int I_IN = 4 * (IN_COLS / 64), I_A = 4 * 16, I_B = 1 * 16, I_OUT = 4 * 16, I_UP = 4 * 64, I_DN = 16 * 16, I_L = I_IN + I_A + I_B + I_OUT + I_UP + I_DN;
        for (int it = bx; it < 2 * I_L; it += G) {
            const int l = it / I_L; int r = it % I_L; bf16* wt = WT + (size_t)l * WT_LAYER;
            if (r < I_IN) { conv_item(a.w_in + (size_t)l * D * IN_COLS, D, IN_COLS, wt + WT_IN, QKV_COLS, scr, r, wid0); continue; } r -= I_IN;
            if (r < I_A) { conv_item(a.w_branch_a + (size_t)l * D * D, D, D, wt + WT_A, 0, scr, r, wid0); continue; } r -= I_A;
            if (r < I_B) { conv_item(a.w_branch_b + (size_t)l * 256 * D, 256, D, wt + WT_B, 0, scr, r, wid0); continue; } r -= I_B;
            if (r < I_OUT) { conv_item(a.w_out + (size_t)l * D * D, D, D, wt + WT_OUT, 0, scr, r, wid0); continue; } r -= I_OUT;
            if (r < I_UP) { conv_item(a.w_mlp_up + (size_t)l * D * FF, D, FF, wt + WT_UP, 0, scr, r, wid0); continue; } r -= I_UP;
            conv_item(a.w_mlp_down + (size_t)l * FF * D, FF, D, wt + WT_DN, 0, scr, r, wid0);
        }
        {
            LAS float* in_s = (LAS float*)lds; LAS float* red = (LAS float*)(lds + 32768);
            bool filled = false;
            for (int it = bx; it < 2 * 48; it += G) {
                if (!filled) { for (int i = tid; i < 8192; i += NTHREADS) { const int k = i >> 3, b = i & 7; const float v = a.c[b * D + k]; in_s[i] = v / (1.0f + __expf(-v)); } __syncthreads(); filled = true; }
                const int l = it / 48, nb = it % 48;
                gemv8_item(a.ada_w + (size_t)l * D * 6144, 6144, a.ada_b + l * 6144, mod + l * 8 * 6144, 6144, nb * 128, in_s, red, wid0);
            }
            __syncthreads();
        }
        for (int i = bx * NTHREADS + tid; i < T * 8; i += G * NTHREADS) {
            const int t = i >> 3, f = i & 7;
            float fr = 1.0f;
            fr = (f == 1) ? 0.19392274474868576f : fr; fr = (f == 2) ? 0.03760603093086393f : fr; fr = (f == 3) ? 0.007292664737217109f : fr; fr = (f == 4) ? 0.001414213562373095f : fr;
            fr = (f == 5) ? 0.0002742481756762073f : fr; fr = (f == 6) ? 5.318295896944988e-05f : fr; fr = (f == 7) ? 1.031338537721246e-05f : fr;
            const float ang = (float)a.pos[t] * fr;
            const double ad = (double)ang; const double kk = __builtin_rint(ad * 0.15915494309189535); const float rd = (float)(ad - kk * 6.283185307179586);
            cosT[i] = __cosf(rd); sinT[i] = __sinf(rd);
        }
        for (int i = bx * NTHREADS + tid; i < 3 * T; i += G * NTHREADS) rowss[T + i] = 0.f;
    }
    grid.sync();
    int vb_ = bx;
    if (G == 256) { bool even = true; for (int j = 0; j < 8; ++j) even = even && (__hip_atomic_load((unsigned*)ws + 3584 + 64 * j, __ATOMIC_RELAXED, __HIP_MEMORY_SCOPE_AGENT) == 32u);
        if (even) vb_ = (int)bar_st[2] * 8 + (int)xbar.x; }
    const int vb = __builtin_amdgcn_readfirstlane(vb_);
    {
        FRESH_IDS();
        LAS float* in_s = (LAS float*)lds; LAS float* red = (LAS float*)(lds + 32768);
        constexpr int NI_IN = IN_COLS / 128, NI_UP = FF / 128, NI_L = NI_IN + NI_UP;
        for (int it = vb; it < 2 * NI_L; it += G) {
            const int l = it / NI_L, r = it % NI_L; const bool up = r >= NI_IN;
            const float* sh = mod + l * 8 * 6144 + (up ? 3 * 1024 : 0);
            for (int i = tid; i < 8192; i += NTHREADS) { const int k = i >> 3, b = i & 7; in_s[i] = sh[b * 6144 + k]; }
            __syncthreads();
            if (!up) gemv8_item(a.w_in + (size_t)l * D * IN_COLS, IN_COLS, nullptr, sbin + l * 8 * IN_COLS, IN_COLS, r * 128, in_s, red, wid0);
            else gemv8_item(a.w_mlp_up + (size_t)l * D * FF, FF, nullptr, sbup + l * 8 * FF, FF, (r - NI_IN) * 128, in_s, red, wid0);
        }
        const int gw = vb * NWAVES + wid, NGW = G * NWAVES;
        for (int m0 = gw; m0 < T; m0 += 4 * NGW) {
            f32x4 v[4][4], sc[4][4];
#pragma unroll
            for (int rr = 0; rr < 4; ++rr) { const int mv = m0 + rr * NGW, m = mv < T ? mv : m0, b = m >> 12;
                const f32x4* xr = (const f32x4*)(a.x + (size_t)m * D) + lane; const f32x4* sr = (const f32x4*)(mod + b * 6144 + 1024) + lane;
#pragma unroll
                for (int j = 0; j < 4; ++j) { v[rr][j] = xr[64 * j]; sc[rr][j] = sr[64 * j]; } }
            const f32x4* gr = (const f32x4*)(a.norm_mix_g) + lane;
#pragma unroll
            for (int rr = 0; rr < 4; ++rr) { const int mv = m0 + rr * NGW, m = mv < T ? mv : m0;
                unsigned long long* o8 = (unsigned long long*)(XS + (size_t)m * D) + lane;
                float s = 0.f;
#pragma unroll
                for (int j = 0; j < 4; ++j) { const f32x4 x4 = v[rr][j]; s += (x4.x * x4.x + x4.y * x4.y) + (x4.z * x4.z + x4.w * x4.w);
                    const f32x4 w = x4 * gr[64 * j] * (sc[rr][j] + 1.0f);
                    o8[64 * j] = (unsigned long long)pk2(w.x, w.y) | ((unsigned long long)pk2(w.z, w.w) << 32); }
                s = att::wave_sum(s);
                if (lane == 0) rowss[m] = s; }
        }
    }
    GRID_BAR();

    for (int l = 0; l < DEPTH; ++l) {
        const bf16* wt = WT + (size_t)l * WT_LAYER;
        const float* modl = mod + l * 8 * 6144;
        const float* rs_mix = rowss + (size_t)(2 * l) * T; float* rs_mlp = rowss + (size_t)(2 * l + 1) * T;
        {
            pg8::Gemm g{XS, wt + WT_IN, T, QKV_COLS, D}; pg8::StaticOrder S; S.init(T, QKV_COLS, G, vb);
            pg8::EpiQKV E{QA, KA, VA, QB, KB, VB, rs_mix, sbin + l * 8 * IN_COLS, a.qk_gain_a + l * 128, a.qk_gain_b + l * 128, cosT, sinT};
            pg8::gemm_phase<pg8::EpiQKV, pg8::StaticOrder, true, true>(lds, g, S, E, wid0);
        }
        GRID_BAR();
        {
            FRESH_IDS();
            const float ga_q = att::wave_max(fabsf(a.qk_gain_a[l * 128 + lane])), ga_k = att::wave_max(fabsf(a.qk_gain_a[l * 128 + 64 + lane]));
            const float gb_q = att::wave_max(fabsf(a.qk_gain_b[l * 128 + lane])), gb_k = att::wave_max(fabsf(a.qk_gain_b[l * 128 + 64 + lane]));
            const float negMa = -(pg8::QK_C2 * 64.0f) * ga_q * ga_k, negMb = -(pg8::QK_C2 * 64.0f) * gb_q * gb_k;
            const float lam_init = __int_as_float(__builtin_amdgcn_readfirstlane(__float_as_int(0.8f - 0.6f * expf(-0.3f * (float)l))));
            const float* lv = a.lambda_a + l * 256;
            const float d1 = att::wave_sum(lv[lane] * lv[64 + lane]), d2 = att::wave_sum(lv[128 + lane] * lv[192 + lane]);
            const float lam = __int_as_float(__builtin_amdgcn_readfirstlane(__float_as_int(expf(d1) - expf(d2) + lam_init)));
            {
                att::BTensors TB{QB, KB, VB, OB};
                for (int u = vb; u < 256; u += G) { const int gidx = (G == 256) ? ((u & 7) * 32 + (u >> 3)) : u; att::attn_b_block(lds, TB, gidx >> 5, (gidx >> 3) & 3, gidx & 7, wid0); }
                __syncthreads();
            }
            {
                att::ATensors TA{QA, KA, VA, QA, a.qk_gain_a + l * 128, lv, a.subln_g_a + l * 128, lam_init};
#ifdef PROBE_A2
                { att::ATensors TD{QA, KA, VA, U, a.qk_gain_a + l * 128, lv, a.subln_g_a + l * 128, lam_init};
                  const int x = vb & 7, idx = vb >> 3;
                  for (int rd = 0; rd < 4; ++rd) { const int pr = rd * 16 + x * 2 + (idx >> 4); att::attn_a_unit2(lds, TD, pr >> 3, pr & 7, idx & 15, lam, wid0); } }
#endif
                if (G == 256) {
                    const int x = vb & 7, idx = vb >> 3;
                    for (int rd = 0; rd < 4; ++rd) { const int pr = rd * 16 + x * 2 + (idx >> 4); att::attn_a_unit2(lds, TA, pr >> 3, pr & 7, idx & 15, lam, wid0); }
                } else
                for (int it = vb; it < 8 * 8 * 16; it += G) {
                    const int qb = it & 15, h = (it >> 4) & 7, b = it >> 7;
                    att::attn_a_unit2(lds, TA, b, h, qb, lam, wid0);
                }
            }
        }
        GRID_BAR();
        {
            pg8::StaticOrder S; S.init(T, D, G, vb);
            { pg8::Gemm g{XS, wt + WT_IN + (size_t)(QKV_COLS + 1024) * D, T, D, D};
              pg8::EpiGate<false> E{TMP1, rs_mix, sbin + l * 8 * IN_COLS + QKV_COLS + 1024, a.gate_bias + l * 2048 + 1024};
              pg8::gemm_phase<pg8::EpiGate<false>, pg8::StaticOrder, true, true>(lds, g, S, E, wid0); }
            { pg8::Gemm g{OB, wt + WT_B, T, D, 256}; pg8::EpiMulInPlace E{TMP1};
              pg8::gemm_phase<pg8::EpiMulInPlace, pg8::StaticOrder, true, true>(lds, g, S, E, wid0); }
            { pg8::Gemm g{XS, wt + WT_IN + (size_t)QKV_COLS * D, T, D, D};
              pg8::EpiGate<false> E{GA, rs_mix, sbin + l * 8 * IN_COLS + QKV_COLS, a.gate_bias + l * 2048};
              pg8::gemm_phase<pg8::EpiGate<false>, pg8::StaticOrder, true, true>(lds, g, S, E, wid0); }
            { pg8::Gemm g{QA, wt + WT_A, T, D, D}; pg8::EpiMerge E{TMP1, GA, U};
              pg8::gemm_phase<pg8::EpiMerge, pg8::StaticOrder, true, true>(lds, g, S, E, wid0); }
        }
        GRID_BAR();
        {
            pg8::Gemm g{U, wt + WT_OUT, T, D, D}; pg8::StaticOrder S; S.init(T, D, G, vb);
            pg8::EpiResid E{l == 0 ? a.x : a.out, a.out, modl + 2 * 1024, XS, a.norm_mlp_g + l * D, modl + 4 * 1024, rs_mlp};
            pg8::gemm_phase<pg8::EpiResid, pg8::StaticOrder, true, true>(lds, g, S, E, wid0);
        }
        GRID_BAR();
        {
            pg8::Gemm g{XS, wt + WT_UP, T, FF, D}; pg8::StaticOrder S; S.init(T, FF, G, vb);
            pg8::EpiUp E{H, rs_mlp, sbup + l * 8 * FF};
            pg8::gemm_phase<pg8::EpiUp, pg8::StaticOrder, true, true>(lds, g, S, E, wid0);
        }
        GRID_BAR();
        {
            pg8::Gemm g{H, wt + WT_DN, T, D, FF}; pg8::StaticOrder S; S.init(T, D, G, vb);
            const bool nxt = l + 1 < DEPTH;
            pg8::EpiResid E{a.out, a.out, modl + 5 * 1024, nxt ? XS : nullptr, a.norm_mix_g + (l + 1) * D, mod + (l + 1) * 8 * 6144 + 1024, rowss + (size_t)(2 * l + 2) * T};
            pg8::gemm_phase<pg8::EpiResid, pg8::StaticOrder, true, true>(lds, g, S, E, wid0);
        }
        if (l + 1 < DEPTH) GRID_BAR();
    }
}

extern "C" void kernel_launch(void* const* d_in, const int* in_sizes, int n_in, void* d_out, int out_size, void* d_ws, size_t ws_size, hipStream_t stream) {
    static int grid = 0;
    if (grid == 0) {
        if (n_in != 18 || out_size != T * D || ws_size < WS_END) { fprintf(stderr, "kernel_launch: unexpected shapes (n_in %d out %d ws %zu)\n", n_in, out_size, ws_size); grid = -1; return; }
        int dev = 0, cus = 0, per_cu = 0;
        hipGetDevice(&dev); hipDeviceGetAttribute(&cus, hipDeviceAttributeMultiprocessorCount, dev);
        if (hipFuncSetAttribute((const void*)fwd_megakernel, hipFuncAttributeMaxDynamicSharedMemorySize, LDS_BYTES) != hipSuccess) { fprintf(stderr, "kernel_launch: hipFuncSetAttribute failed\n"); grid = -1; return; }
        if (hipOccupancyMaxActiveBlocksPerMultiprocessor(&per_cu, (const void*)fwd_megakernel, NTHREADS, LDS_BYTES) != hipSuccess || per_cu < 1) { fprintf(stderr, "kernel_launch: occupancy query failed (%d)\n", per_cu); per_cu = 1; }
        (void)hipGetLastError();
        grid = cus * per_cu;
    }
    if (grid < 0) return;
    Args a{};
    a.x = (const float*)d_in[0]; a.c = (const float*)d_in[1]; a.pos = (const int*)d_in[2];
    a.ada_w = (const float*)d_in[3]; a.ada_b = (const float*)d_in[4]; a.norm_mix_g = (const float*)d_in[5]; a.norm_mlp_g = (const float*)d_in[6]; a.w_in = (const float*)d_in[7];
    a.qk_gain_a = (const float*)d_in[8]; a.lambda_a = (const float*)d_in[9]; a.subln_g_a = (const float*)d_in[10]; a.qk_gain_b = (const float*)d_in[11];
    a.w_branch_a = (const float*)d_in[12]; a.w_branch_b = (const float*)d_in[13]; a.gate_bias = (const float*)d_in[14]; a.w_out = (const float*)d_in[15];
    a.w_mlp_up = (const float*)d_in[16]; a.w_mlp_down = (const float*)d_in[17];
    a.out = (float*)d_out; a.ws = (unsigned char*)d_ws;
    if (hipMemsetAsync(d_ws, 0, 16384, stream) != hipSuccess) { fprintf(stderr, "kernel_launch: memset failed\n"); return; }
    void* args[] = {&a};
    hipError_t e = hipLaunchCooperativeKernel((const void*)fwd_megakernel, dim3(grid), dim3(NTHREADS), args, LDS_BYTES, stream);
    if (e != hipSuccess) fprintf(stderr, "cooperative launch failed: %s (grid %d)\n", hipGetErrorString(e), grid);
}
```

```cpp
#include <hip/hip_runtime.h>
#include <hip/hip_cooperative_groups.h>
#include <cstdio>
#include <cstdint>
__device__ __forceinline__ int fresh_lane() { int l; asm volatile("v_mbcnt_lo_u32_b32 %0, -1, 0\n\tv_mbcnt_hi_u32_b32 %0, -1, %0" : "=v"(l)); return l; }
template <int K> __device__ __forceinline__ float shx(float v) { return __int_as_float(__builtin_amdgcn_ds_swizzle(__float_as_int(v), (K << 10) | 0x1f)); }
__device__ __forceinline__ float add_x32(float v) { auto rr = __builtin_amdgcn_permlane32_swap(__float_as_uint(v), __float_as_uint(v), false, false); return __uint_as_float(rr[0]) + __uint_as_float(rr[1]); }
__device__ __forceinline__ float max_x32(float v) { auto rr = __builtin_amdgcn_permlane32_swap(__float_as_uint(v), __float_as_uint(v), false, false); return fmaxf(__uint_as_float(rr[0]), __uint_as_float(rr[1])); }
namespace pg8 {
#define PG8_LAS __attribute__((address_space(3)))
typedef unsigned short bf16_t;
typedef short bf16x8 __attribute__((ext_vector_type(8)));
typedef float f32x4 __attribute__((ext_vector_type(4)));
typedef unsigned u32x4 __attribute__((ext_vector_type(4)));
constexpr int BM = 256, BK = 64, HALF = 128, HTB = HALF * BK * 2  , STAGE_BYTES = 8 * HTB, NXCD = 8, WGM = 8;

__host__ __device__ __forceinline__ int lds_byte(int r, int c) { const int st = (r >> 4) * 2 + (c >> 5), rr = r & 15, cc = c & 31, ob = rr * 64 + cc * 2; return st * 1024 + (ob ^ (((ob >> 9) & 1) << 5)); }
__host__ __device__ __forceinline__ void stage_rc(int b, int& R, int& C) { const int st = b / 1024, sb = b % 1024, swz = sb ^ (((sb >> 9) & 1) << 5); R = (st >> 1) * 16 + swz / 64; C = (st & 1) * 32 + (swz % 64) / 2; }
__host__ __device__ __forceinline__ int perm32(int rho) { const int n = rho >> 4, i = rho & 15; return 8 * (i >> 2) + 4 * n + (i & 3); }

struct Unit { int pm, pn; };
struct Gemm { const bf16_t* A; const bf16_t* Bt; int M, N, K; };

struct StaticOrder {
    int nM, nN, nwg, G, c;
    __host__ __device__ void init(int M, int N, int G_, int c_) { nM = M / BM; nN = N / BM; nwg = nM * nN; G = G_; c = c_; }
    __host__ __device__ bool next(int i, Unit& u) const {
        const long L = (long)i * G + c; if (L >= nwg) return false;
        int wgid = (int)L; { const int q = nwg / NXCD, r = nwg % NXCD, xcd = wgid % NXCD, off = wgid / NXCD; wgid = (xcd < r ? xcd * (q + 1) : r * (q + 1) + (xcd - r) * q) + off; }
        const int nig = WGM * nN, gid = wgid / nig, fm = gid * WGM, gsz = (nM - fm) < WGM ? (nM - fm) : WGM;
        u.pm = fm + ((wgid % nig) % gsz); u.pn = (wgid % nig) / gsz; return true;
    }
    __device__ __forceinline__ void a_ready(const Unit&) const {}
    __device__ __forceinline__ void done(const Unit&) const {}
};

__device__ __forceinline__ unsigned cvt_pk_bf16(float lo, float hi) { unsigned r; asm volatile("v_cvt_pk_bf16_f32 %0, %1, %2" : "=v"(r) : "v"(lo), "v"(hi)); return r; }
typedef float f32x2 __attribute__((ext_vector_type(2)));

__device__ __forceinline__ u32x4 pack8(const f32x4 a, const f32x4 b) { u32x4 w; w.x = cvt_pk_bf16(a[0], a[1]); w.y = cvt_pk_bf16(a[2], a[3]); w.z = cvt_pk_bf16(b[0], b[1]); w.w = cvt_pk_bf16(b[2], b[3]); return w; }
__device__ __forceinline__ void unpack8(const u32x4 w, f32x4& a, f32x4& b) {
    a[0] = __uint_as_float(w.x << 16); a[1] = __uint_as_float(w.x & 0xffff0000u); a[2] = __uint_as_float(w.y << 16); a[3] = __uint_as_float(w.y & 0xffff0000u);
    b[0] = __uint_as_float(w.z << 16); b[1] = __uint_as_float(w.z & 0xffff0000u); b[2] = __uint_as_float(w.w << 16); b[3] = __uint_as_float(w.w & 0xffff0000u); }
constexpr float QK_C2 = 0.125f * 1.4426950408889634f;
constexpr float RMS_EPS = 1e-6f;

struct EpiQKV {
    static constexpr bool PERM = true, AFTER_DRAIN = false;
    bf16_t *QA, *KA, *VA, *QB, *KB, *VB;
    const float* rowss;
    const float* sb;
    const float* gain_a;
    const float* gain_b;
    const float* cs; const float* sn;
    __device__ __forceinline__ void operator()(const f32x4 (&acc)[2][2][4][2], const Unit& u, int wr, int wc, int fr, int fq) const {
        const int tile = u.pn, b = u.pm >> 4;
        bf16_t* dst; int ld, ctile; int kind;
        const float* gain;
        if (tile < 4)       { dst = QA; ld = 1024; ctile = tile;      kind = 0; gain = gain_a; }
        else if (tile < 8)  { dst = KA; ld = 1024; ctile = tile - 4;  kind = 1; gain = gain_a + 64; }
        else if (tile < 12) { dst = VA; ld = 1024; ctile = tile - 8;  kind = 2; gain = gain_a; }
        else if (tile < 15) { dst = QB; ld = 768;  ctile = tile - 12; kind = 0; gain = gain_b; }
        else if (tile < 18) { dst = KB; ld = 768;  ctile = tile - 15; kind = 1; gain = gain_b + 64; }
        else                { dst = VB; ld = 768;  ctile = tile - 18; kind = 2; gain = gain_b; }
        const int oc0 = 64 * wc + 8 * fq;
        f32x4 bv[2][2], gv[2][2];
#pragma unroll
        for (int bj = 0; bj < 2; ++bj)
#pragma unroll
            for (int n = 0; n < 2; ++n) {
                bv[bj][n] = *(const f32x4*)(sb + (size_t)b * 7424 + tile * 256 + oc0 + 32 * bj + 4 * n);
                gv[bj][n] = *(const f32x4*)(gain + 32 * bj + 8 * fq + 4 * n);
            }
        const float qs = (kind == 0) ? QK_C2 : 1.0f;
#pragma unroll
        for (int ai = 0; ai < 2; ++ai)
#pragma unroll
            for (int m = 0; m < 4; ++m) {
                const int row = u.pm * BM + ai * HALF + wr * 64 + m * 16 + fr;
                const float rinv = __builtin_amdgcn_rsqf(rowss[row] * (1.0f / 1024.0f) + RMS_EPS);
                f32x4 v[2][2];
#pragma unroll
                for (int bj = 0; bj < 2; ++bj)
#pragma unroll
                    for (int n = 0; n < 2; ++n) v[bj][n] = acc[ai][bj][m][n] * rinv + bv[bj][n];
                if (kind != 2) {
                    float ss = 0.f;
#pragma unroll
                    for (int bj = 0; bj < 2; ++bj)
#pragma unroll
                        for (int n = 0; n < 2; ++n) { const f32x4 x = v[bj][n]; ss += (x[0] * x[0] + x[1] * x[1]) + (x[2] * x[2] + x[3] * x[3]); }
                    ss += shx<16>(ss); ss = add_x32(ss);
                    const float rr = __builtin_amdgcn_rsqf(ss * (1.0f / 64.0f) + RMS_EPS) * qs;
#pragma unroll
                    for (int bj = 0; bj < 2; ++bj)
#pragma unroll
                        for (int n = 0; n < 2; ++n) v[bj][n] = v[bj][n] * gv[bj][n] * rr;
#pragma unroll
                    for (int n = 0; n < 2; ++n) {
                        const f32x4 c4 = *(const f32x4*)(cs + (size_t)row * 8 + 4 * n), s4 = *(const f32x4*)(sn + (size_t)row * 8 + 4 * n);
                        f32x4 pr;
#pragma unroll
                        for (int e = 0; e < 4; ++e) pr[e] = shx<16>(v[0][n][e]);
                        if (fq == 0) v[0][n] = v[0][n] * c4 - pr * s4;
                        else if (fq == 1) v[0][n] = v[0][n] * c4 + pr * s4;
                    }
                }
                bf16_t* rowp = dst + (size_t)row * ld + ctile * 256 + oc0;
                *(u32x4*)(rowp) = pack8(v[0][0], v[0][1]);
                *(u32x4*)(rowp + 32) = pack8(v[1][0], v[1][1]);
            }
    }
};

template <bool F32OUT> struct EpiGate {
    static constexpr bool PERM = true, AFTER_DRAIN = false;
    void* out; const float* rowss; const float* sb; const float* gbias;
    __device__ __forceinline__ void operator()(const f32x4 (&acc)[2][2][4][2], const Unit& u, int wr, int wc, int fr, int fq) const {
        const int b = u.pm >> 4; const int col0 = u.pn * BM + wc * 32 + 8 * fq;
        f32x4 bv[2][2];
#pragma unroll
        for (int bj = 0; bj < 2; ++bj)
#pragma unroll
            for (int n = 0; n < 2; ++n) bv[bj][n] = *(const f32x4*)(sb + (size_t)b * 7424 + col0 + bj * HALF + 4 * n) + *(const f32x4*)(gbias + col0 + bj * HALF + 4 * n);
#pragma unroll
        for (int ai = 0; ai < 2; ++ai)
#pragma unroll
            for (int m = 0; m < 4; ++m) {
                const int row = u.pm * BM + ai * HALF + wr * 64 + m * 16 + fr;
                const float rinv = __builtin_amdgcn_rsqf(rowss[row] * (1.0f / 1024.0f) + RMS_EPS);
#pragma unroll
                for (int bj = 0; bj < 2; ++bj) {
                    f32x4 v[2];
#pragma unroll
                    for (int n = 0; n < 2; ++n) { const f32x4 z = acc[ai][bj][m][n] * rinv + bv[bj][n];
#pragma unroll
                        for (int e = 0; e < 4; ++e) v[n][e] = __builtin_amdgcn_rcpf(1.0f + __builtin_amdgcn_exp2f(-1.4426950408889634f * z[e])); }
                    const size_t off = (size_t)row * 1024 + col0 + bj * HALF;
                    if (F32OUT) { *(f32x4*)((float*)out + off) = v[0]; *(f32x4*)((float*)out + off + 4) = v[1]; }
                    else *(u32x4*)((bf16_t*)out + off) = pack8(v[0], v[1]);
                }
            }
    }
};
struct EpiMulInPlace {
    static constexpr bool PERM = true, AFTER_DRAIN = false;
    bf16_t* tmp;
    __device__ __forceinline__ void operator()(const f32x4 (&acc)[2][2][4][2], const Unit& u, int wr, int wc, int fr, int fq) const {
        const int col0 = u.pn * BM + wc * 32 + 8 * fq;
#pragma unroll
        for (int ai = 0; ai < 2; ++ai)
#pragma unroll
            for (int m = 0; m < 4; ++m) {
                const int row = u.pm * BM + ai * HALF + wr * 64 + m * 16 + fr;
#pragma unroll
                for (int bj = 0; bj < 2; ++bj) { bf16_t* p = tmp + (size_t)row * 1024 + col0 + bj * HALF;
                    f32x4 t0, t1; unpack8(*(const u32x4*)p, t0, t1);
                    *(u32x4*)p = pack8(t0 * acc[ai][bj][m][0], t1 * acc[ai][bj][m][1]); }
            }
    }
};
struct EpiMerge {
    static constexpr bool PERM = true, AFTER_DRAIN = false;
    const bf16_t* tmp1; const bf16_t* ga; bf16_t* U;
    __device__ __forceinline__ void operator()(const f32x4 (&acc)[2][2][4][2], const Unit& u, int wr, int wc, int fr, int fq) const {
        const int col0 = u.pn * BM + wc * 32 + 8 * fq;
#pragma unroll
        for (int ai = 0; ai < 2; ++ai)
#pragma unroll
            for (int m = 0; m < 4; ++m) {
                const int row = u.pm * BM + ai * HALF + wr * 64 + m * 16 + fr;
#pragma unroll
                for (int bj = 0; bj < 2; ++bj) { const size_t off = (size_t)row * 1024 + col0 + bj * HALF;
                    f32x4 t0, t1, g0, g1; unpack8(*(const u32x4*)(tmp1 + off), t0, t1); unpack8(*(const u32x4*)(ga + off), g0, g1);
                    *(u32x4*)(U + off) = pack8(g0 * acc[ai][bj][m][0] + t0, g1 * acc[ai][bj][m][1] + t1); }
            }
    }
};
struct EpiResid {
    static constexpr bool PERM = true, AFTER_DRAIN = false;
    const float* xi; float* xo; const float* gate;
    bf16_t* xs; const float* ng; const float* scl; float* rowss;
    __device__ __forceinline__ void operator()(const f32x4 (&acc)[2][2][4][2], const Unit& u, int wr, int wc, int fr, int fq) const {
        const int b = u.pm >> 4; const int col0 = u.pn * BM + wc * 32 + 8 * fq;
        f32x4 gt[2][2], gs[2][2];
#pragma unroll
        for (int bj = 0; bj < 2; ++bj)
#pragma unroll
            for (int n = 0; n < 2; ++n) { const int c = col0 + bj * HALF + 4 * n;
                gt[bj][n] = *(const f32x4*)(gate + (size_t)b * 6144 + c);
                if (xs) gs[bj][n] = *(const f32x4*)(ng + c) * (*(const f32x4*)(scl + (size_t)b * 6144 + c) + 1.0f); else gs[bj][n] = (f32x4){0.f, 0.f, 0.f, 0.f}; }
#pragma unroll
        for (int ai = 0; ai < 2; ++ai)
#pragma unroll
            for (int m = 0; m < 4; ++m) {
                const int row = u.pm * BM + ai * HALF + wr * 64 + m * 16 + fr;
                float ss = 0.f;
#pragma unroll
                for (int bj = 0; bj < 2; ++bj) { const size_t off = (size_t)row * 1024 + col0 + bj * HALF;
                    const f32x4 x0 = *(const f32x4*)(xi + off) + gt[bj][0] * acc[ai][bj][m][0], x1 = *(const f32x4*)(xi + off + 4) + gt[bj][1] * acc[ai][bj][m][1];
                    *(f32x4*)(xo + off) = x0; *(f32x4*)(xo + off + 4) = x1;
                    if (xs) { ss += (x0[0] * x0[0] + x0[1] * x0[1]) + (x0[2] * x0[2] + x0[3] * x0[3]) + (x1[0] * x1[0] + x1[1] * x1[1]) + (x1[2] * x1[2] + x1[3] * x1[3]);
                        *(u32x4*)(xs + off) = pack8(x0 * gs[bj][0], x1 * gs[bj][1]); } }
                if (xs) { ss += shx<16>(ss); ss = add_x32(ss); if (fq == 0) atomicAdd(rowss + row, ss); }
            }
    }
};
struct EpiUp {
    static constexpr bool PERM = true, AFTER_DRAIN = false;
    bf16_t* H; const float* rowss; const float* sb;
    __device__ __forceinline__ void operator()(const f32x4 (&acc)[2][2][4][2], const Unit& u, int wr, int wc, int fr, int fq) const {
        const int b = u.pm >> 4; const int col0 = u.pn * BM + wc * 32 + 8 * fq;
        f32x4 bv[2][2];
#pragma unroll
        for (int bj = 0; bj < 2; ++bj)
#pragma unroll
            for (int n = 0; n < 2; ++n) bv[bj][n] = *(const f32x4*)(sb + (size_t)b * 4096 + col0 + bj * HALF + 4 * n);
#pragma unroll
        for (int ai = 0; ai < 2; ++ai)
#pragma unroll
            for (int m = 0; m < 4; ++m) {
                const int row = u.pm * BM + ai * HALF + wr * 64 + m * 16 + fr;
                const float rinv = __builtin_amdgcn_rsqf(rowss[row] * (1.0f / 1024.0f) + RMS_EPS);
#pragma unroll
                for (int bj = 0; bj < 2; ++bj) {
                    f32x4 v[2];
#pragma unroll
                    for (int n = 0; n < 2; ++n) { f32x4 z = acc[ai][bj][m][n] * rinv + bv[bj][n];
#pragma unroll
                        for (int e = 0; e < 4; ++e) { const float r = fmaxf(z[e], 0.f); z[e] = r * r; } v[n] = z; }
                    *(u32x4*)(H + (size_t)row * 4096 + col0 + bj * HALF) = pack8(v[0], v[1]);
                }
            }
    }
};
template <class Epi, class Sched, bool ALIGN_EPI = false, bool SP2 = false>
__device__ __forceinline__ void gemm_phase(PG8_LAS unsigned char* lds, const Gemm g, const Sched& S, const Epi& E, const int wid0) {
    const int tid_ = wid0 * 64 + fresh_lane();
    const int tid = tid_, wid = __builtin_amdgcn_readfirstlane(tid >> 6), lane = tid & 63, wr = wid >> 2, wc = wid & 3, fr = lane & 15, fq = lane >> 4;
    const int K = g.K, nt = K / BK;
    unsigned voffA[2], voffB[2];
#pragma unroll
    for (int i = 0; i < 2; ++i) { int R, C; stage_rc(tid * 16 + i * 8192, R, C); const int Rb = Epi::PERM ? ((R & ~31) + perm32(R & 31)) : R;
        voffA[i] = (unsigned)(R * K + C) * 2u; voffB[i] = (unsigned)(Rb * K + C) * 2u; }
    const size_t kstep = (size_t)(BK * 2);
    const size_t hstep = (size_t)HALF * K * 2;
    const size_t tstep = 2 * hstep;
    const unsigned ldsw = (unsigned)wid * 1024u;
    const int aoff = lds_byte(wr * 64 + fr, fq * 8), boff = lds_byte(wc * 32 + fr, fq * 8);
#define PG8_SA(b, h) (((b) * 2 + (h)) * HTB)
#define PG8_SB(b, h) ((4 + (b) * 2 + (h)) * HTB)
#define PG8_STAGE(bufoff, gbase, voff) do { _Pragma("unroll") for (int _i = 0; _i < 2; ++_i) \
        __builtin_amdgcn_global_load_lds((const unsigned*)((const char*)(gbase) + (voff)[_i]), (PG8_LAS unsigned*)(lds + (bufoff) + ldsw + _i * 8192), 16, 0, 0); } while (0)
#define PG8_LDA(dst, b, h) do { _Pragma("unroll") for (int m = 0; m < 4; ++m) _Pragma("unroll") for (int k = 0; k < 2; ++k) dst[m][k] = *(const PG8_LAS bf16x8*)(lds + PG8_SA(b, h) + aoff + m * 2048 + k * 1024); } while (0)
#define PG8_LDB(dst, b, h) do { _Pragma("unroll") for (int n = 0; n < 2; ++n) _Pragma("unroll") for (int k = 0; k < 2; ++k) dst[n][k] = *(const PG8_LAS bf16x8*)(lds + PG8_SB(b, h) + boff + n * 2048 + k * 1024); } while (0)
#define PG8_MMA(ai, bj, At, Bt) do { __builtin_amdgcn_s_setprio(1); _Pragma("unroll") for (int m = 0; m < 4; ++m) _Pragma("unroll") for (int n = 0; n < 2; ++n) _Pragma("unroll") for (int k = 0; k < 2; ++k) \
        acc[ai][bj][m][n] = __builtin_amdgcn_mfma_f32_16x16x32_bf16(Bt[n][k], At[m][k], acc[ai][bj][m][n], 0, 0, 0); __builtin_amdgcn_s_setprio(0); } while (0)
#define PG8_WAIT_V(n) asm volatile("s_waitcnt vmcnt(" #n ")" ::: "memory")
#define PG8_WAIT_L(n) asm volatile("s_waitcnt lgkmcnt(" #n ")" ::: "memory")
#define PG8_BAR __builtin_amdgcn_s_barrier()
#define PG8_SCHED __builtin_amdgcn_sched_barrier(0)
    Unit cur, nxt; int ui = 0;
    if (!S.next(0, cur)) return;
    f32x4 acc[2][2][4][2];
#pragma unroll
    for (int a = 0; a < 2; ++a)
#pragma unroll
        for (int b = 0; b < 2; ++b)
#pragma unroll
            for (int m = 0; m < 4; ++m)
#pragma unroll
                for (int n = 0; n < 2; ++n) acc[a][b][m][n] = (f32x4){0.f, 0.f, 0.f, 0.f};
    bf16x8 At[4][2], B0[2][2], B1[2][2];
    const char* cA = (const char*)g.A + (size_t)cur.pm * tstep; const char* cB = (const char*)g.Bt + (size_t)cur.pn * tstep;
    S.a_ready(cur);
    if constexpr (SP2) {
        PG8_STAGE(PG8_SB(0, 0), cB, voffB); PG8_STAGE(PG8_SB(0, 1), cB + hstep, voffB); PG8_STAGE(PG8_SA(0, 0), cA, voffA); PG8_STAGE(PG8_SA(0, 1), cA + hstep, voffA);
        if (wr == 1) PG8_BAR;
        PG8_WAIT_V(2); PG8_BAR;
        PG8_STAGE(PG8_SB(1, 0), cB + kstep, voffB); PG8_STAGE(PG8_SA(1, 0), cA + kstep, voffA); PG8_STAGE(PG8_SB(1, 1), cB + hstep + kstep, voffB);
        PG8_WAIT_V(6); PG8_BAR;
    } else {
        PG8_STAGE(PG8_SB(0, 0), cB, voffB); PG8_STAGE(PG8_SA(0, 0), cA, voffA); PG8_STAGE(PG8_SB(0, 1), cB + hstep, voffB); PG8_STAGE(PG8_SA(0, 1), cA + hstep, voffA);
        if (wr == 1) PG8_BAR;
        PG8_WAIT_V(4); PG8_BAR;
        PG8_STAGE(PG8_SB(1, 0), cB + kstep, voffB); PG8_STAGE(PG8_SA(1, 0), cA + kstep, voffA); PG8_STAGE(PG8_SB(1, 1), cB + hstep + kstep, voffB);
        PG8_WAIT_V(6); PG8_BAR;
    }
    for (;;) {
        const bool has_next = S.next(ui + 1, nxt);
        const char* nA = has_next ? (const char*)g.A + (size_t)nxt.pm * tstep : cA; const char* nB = has_next ? (const char*)g.Bt + (size_t)nxt.pn * tstep : cB;
        for (int t = 0; t < nt; t += 2) {
            const bool last = (t == nt - 2);
            const char* a1 = cA + (size_t)(t + 1) * kstep;
            const char* a2 = last ? nA : cA + (size_t)(t + 2) * kstep; const char* b2 = last ? nB : cB + (size_t)(t + 2) * kstep;
            const char* a3 = a2 + kstep; const char* b3 = b2 + kstep;
            if (last && has_next) S.a_ready(nxt);
            if constexpr (SP2) {
            PG8_LDB(B0, 0, 0); PG8_LDB(B1, 0, 1); PG8_SCHED; PG8_LDA(At, 0, 0); PG8_STAGE(PG8_SA(1, 1), a1 + hstep, voffA);
            PG8_WAIT_V(8); PG8_WAIT_L(0); PG8_BAR; PG8_MMA(0, 0, At, B0); PG8_MMA(0, 1, At, B1); PG8_BAR; PG8_SCHED;
            PG8_LDA(At, 0, 1); PG8_STAGE(PG8_SB(0, 0), b2, voffB); PG8_STAGE(PG8_SB(0, 1), b2 + hstep, voffB); PG8_STAGE(PG8_SA(0, 0), a2, voffA);
            PG8_WAIT_V(8); PG8_WAIT_L(0); PG8_BAR; PG8_MMA(1, 0, At, B0); PG8_MMA(1, 1, At, B1); PG8_BAR; PG8_SCHED;
            PG8_LDB(B0, 1, 0); PG8_LDB(B1, 1, 1); PG8_SCHED; PG8_LDA(At, 1, 0); PG8_STAGE(PG8_SA(0, 1), a2 + hstep, voffA);
            PG8_WAIT_V(8); PG8_WAIT_L(0); PG8_BAR; PG8_MMA(0, 0, At, B0); PG8_MMA(0, 1, At, B1); PG8_BAR; PG8_SCHED;
            PG8_LDA(At, 1, 1); PG8_STAGE(PG8_SB(1, 0), b3, voffB); PG8_STAGE(PG8_SB(1, 1), b3 + hstep, voffB); PG8_STAGE(PG8_SA(1, 0), a3, voffA);
            PG8_WAIT_V(8); PG8_WAIT_L(0); PG8_BAR; PG8_MMA(1, 0, At, B0); PG8_MMA(1, 1, At, B1); PG8_BAR; PG8_SCHED;
            } else {
            PG8_LDB(B0, 0, 0); PG8_SCHED; PG8_LDA(At, 0, 0); PG8_STAGE(PG8_SA(1, 1), a1 + hstep, voffA);
            PG8_WAIT_L(8); PG8_BAR; PG8_WAIT_L(0); PG8_MMA(0, 0, At, B0); PG8_BAR; PG8_SCHED;
            PG8_LDB(B1, 0, 1); PG8_STAGE(PG8_SB(0, 0), b2, voffB);
            PG8_BAR; PG8_WAIT_L(0); PG8_MMA(0, 1, At, B1); PG8_BAR;
            PG8_LDA(At, 0, 1); PG8_STAGE(PG8_SA(0, 0), a2, voffA);
            PG8_BAR; PG8_WAIT_L(0); PG8_MMA(1, 0, At, B0); PG8_BAR; PG8_SCHED;
            PG8_STAGE(PG8_SB(0, 1), b2 + hstep, voffB);
            PG8_WAIT_V(6); PG8_BAR; PG8_MMA(1, 1, At, B1); PG8_BAR;
            PG8_LDB(B0, 1, 0); PG8_SCHED; PG8_LDA(At, 1, 0); PG8_STAGE(PG8_SA(0, 1), a2 + hstep, voffA);
            PG8_WAIT_L(8); PG8_BAR; PG8_WAIT_L(0); PG8_MMA(0, 0, At, B0); PG8_BAR; PG8_SCHED;
            PG8_LDB(B1, 1, 1); PG8_STAGE(PG8_SB(1, 0), b3, voffB);
            PG8_BAR; PG8_WAIT_L(0); PG8_MMA(0, 1, At, B1); PG8_BAR;
            PG8_LDA(At, 1, 1); PG8_STAGE(PG8_SA(1, 0), a3, voffA);
            PG8_BAR; PG8_WAIT_L(0); PG8_MMA(1, 0, At, B0); PG8_BAR; PG8_SCHED;
            PG8_STAGE(PG8_SB(1, 1), b3 + hstep, voffB);
            PG8_WAIT_V(6); PG8_BAR; PG8_MMA(1, 1, At, B1); PG8_BAR;
            }
        }
        if constexpr (ALIGN_EPI) { if (wr == 0) PG8_BAR; }
        if constexpr (!Epi::AFTER_DRAIN) { E(acc, cur, wr, wc, fr, fq); S.done(cur); }
        if (!has_next) break;
#pragma unroll
        for (int a = 0; a < 2; ++a)
#pragma unroll
            for (int b = 0; b < 2; ++b)
#pragma unroll
                for (int m = 0; m < 4; ++m)
#pragma unroll
                    for (int n = 0; n < 2; ++n) acc[a][b][m][n] = (f32x4){0.f, 0.f, 0.f, 0.f};
        cur = nxt; cA = nA; cB = nB; ++ui;
        if constexpr (ALIGN_EPI) { if (wr == 1) PG8_BAR; }
    }
    PG8_WAIT_V(0);
    if constexpr (!ALIGN_EPI) { if (wr == 0) PG8_BAR; }
    PG8_BAR;
    if constexpr (Epi::AFTER_DRAIN) { E.fused(acc, cur, wr, wc, fr, fq, lds, wid, lane); S.done(cur); }
#undef PG8_SA
#undef PG8_SB
#undef PG8_STAGE
#undef PG8_LDA
#undef PG8_LDB
#undef PG8_MMA
#undef PG8_WAIT_V
#undef PG8_WAIT_L
#undef PG8_BAR
#undef PG8_SCHED
}
}

namespace att {
#define ATT_LAS __attribute__((address_space(3)))
typedef unsigned short bf16_t;
typedef short bf16x8 __attribute__((ext_vector_type(8)));
typedef short s16x4 __attribute__((ext_vector_type(4)));
typedef float f32x16 __attribute__((ext_vector_type(16)));
typedef float f32x4 __attribute__((ext_vector_type(4)));
typedef unsigned u32x4 __attribute__((ext_vector_type(4)));
typedef float f32x2_t __attribute__((ext_vector_type(2))); typedef __bf16 bf16x2_t __attribute__((ext_vector_type(2)));
constexpr int SEQ = 4096;
constexpr int KP = 144, VP = 320;
constexpr int KB_ = 64 * KP, VB_ = 64 * VP, BUF = KB_ + VB_;
constexpr int A_LDS = 3 * 8192 + 4 * 16384 + 8 * 256 + 8 * 8192;
constexpr int VPB = 192;
constexpr int B_STAGE = 32 * VPB;
constexpr int B_LDS = 8 * B_STAGE + 8 * 256;

__device__ __forceinline__ int crow(int r, int hi) { return (r & 3) + 8 * (r >> 2) + 4 * hi; }
__device__ __forceinline__ unsigned cvtpk(float lo, float hi) { f32x2_t v = {lo, hi}; bf16x2_t b = __builtin_convertvector(v, bf16x2_t); return __builtin_bit_cast(unsigned, b); }
__device__ __forceinline__ bf16x8 pack_p(const f32x16& p, int s) {
    u32x4 w; w.x = cvtpk(p[8 * s], p[8 * s + 1]); w.y = cvtpk(p[8 * s + 2], p[8 * s + 3]); w.z = cvtpk(p[8 * s + 4], p[8 * s + 5]); w.w = cvtpk(p[8 * s + 6], p[8 * s + 7]);
    return __builtin_bit_cast(bf16x8, w); }
typedef short v4i16_t __attribute__((ext_vector_type(4)));
__device__ __forceinline__ s16x4 vtr(const ATT_LAS unsigned char* p) { return __builtin_bit_cast(s16x4, __builtin_amdgcn_ds_read_tr16_b64_v4i16((ATT_LAS v4i16_t*)p)); }
__device__ __forceinline__ bf16x8 vfrag(const ATT_LAS unsigned char* p, int rowstep8) {
    const s16x4 lo = vtr(p), hi = vtr(p + rowstep8);
    return (bf16x8){lo[0], lo[1], lo[2], lo[3], hi[0], hi[1], hi[2], hi[3]}; }
__device__ __forceinline__ float add_x32_(float v) { auto rr = __builtin_amdgcn_permlane32_swap(__float_as_uint(v), __float_as_uint(v), false, false); return __uint_as_float(rr[0]) + __uint_as_float(rr[1]); }
__device__ __forceinline__ float wave_max(float v) {
    v = fmaxf(v, shx<1>(v)); v = fmaxf(v, shx<2>(v)); v = fmaxf(v, shx<4>(v)); v = fmaxf(v, shx<8>(v)); v = fmaxf(v, shx<16>(v));
    return max_x32(v); }
__device__ __forceinline__ float wave_sum(float v) {
    v += shx<1>(v); v += shx<2>(v); v += shx<4>(v); v += shx<8>(v); v += shx<16>(v);
    return add_x32(v); }

struct ATensors {
    const bf16_t* Q; const bf16_t* K; const bf16_t* V; bf16_t* O;
    const float* gain_a;
    const float* lambda_a;
    const float* subln_g;
    float lam_init;
};

template <int NKS, int NVS> struct ALay {
    static constexpr int KST = 8192, VST = 16384;
    static constexpr int K0 = 0, V0 = NKS * KST, SCR = V0 + NVS * VST, O0 = SCR + 8 * 256, END = O0 + 8 * 8192;
};
__device__ __forceinline__ void a_qk_exp(const ATT_LAS unsigned char* ks, const int (&ko)[4], const bf16x8 (&qr)[4], const f32x16& negm, bf16x8 (&pa)[4], float& lsum) {
    bf16x8 a0[4], a1[4];
#pragma unroll
    for (int d0 = 0; d0 < 4; ++d0) { a0[d0] = *(const ATT_LAS bf16x8*)(ks + ko[d0]); a1[d0] = *(const ATT_LAS bf16x8*)(ks + ko[d0] + 32 * 128); }
    f32x16 p0 = __builtin_amdgcn_mfma_f32_32x32x16_bf16(a0[0], qr[0], negm, 0, 0, 0);
    f32x16 p1 = __builtin_amdgcn_mfma_f32_32x32x16_bf16(a1[0], qr[0], negm, 0, 0, 0);
#pragma unroll
    for (int d0 = 1; d0 < 4; ++d0) {
        p0 = __builtin_amdgcn_mfma_f32_32x32x16_bf16(a0[d0], qr[d0], p0, 0, 0, 0);
        p1 = __builtin_amdgcn_mfma_f32_32x32x16_bf16(a1[d0], qr[d0], p1, 0, 0, 0);
    }
    float sa = 0.f, sb = 0.f;
#pragma unroll
    for (int r = 0; r < 16; ++r) { p0[r] = __builtin_amdgcn_exp2f(p0[r]); sa += p0[r]; }
    pa[0] = pack_p(p0, 0); pa[1] = pack_p(p0, 1);
#pragma unroll
    for (int r = 0; r < 16; ++r) { p1[r] = __builtin_amdgcn_exp2f(p1[r]); sb += p1[r]; }
    pa[2] = pack_p(p1, 0); pa[3] = pack_p(p1, 1);
    lsum += sa + sb;
}
__device__ __forceinline__ void a_pv(const ATT_LAS unsigned char* vs, const int (&vo)[4], const bf16x8 (&pa)[4], f32x16 (&o)[4]) {
    bf16x8 vc[4], vn[4];
#pragma unroll
    for (int db = 0; db < 4; ++db) vc[db] = vfrag(vs + vo[db], 8 * 256);
#pragma unroll
    for (int s = 0; s < 4; ++s) {
        if (s < 3) {
#pragma unroll
            for (int db = 0; db < 4; ++db) vn[db] = vfrag(vs + vo[db] + (s + 1) * 16 * 256, 8 * 256);
        }
        __builtin_amdgcn_sched_barrier(0);
#pragma unroll
        for (int db = 0; db < 4; ++db) o[db] = __builtin_amdgcn_mfma_f32_32x32x16_bf16(pa[s], vc[db], o[db], 0, 0, 0);
        __builtin_amdgcn_sched_barrier(0);
#pragma unroll
        for (int db = 0; db < 4; ++db) vc[db] = vn[db];
    }
}
__device__ __forceinline__ void glds16(const void* gsrc, unsigned lds_dst) { unsigned keep;
    asm volatile("s_mov_b32 %0, m0\n\ts_mov_b32 m0, %2\n\ts_nop 0\n\tglobal_load_lds_dwordx4 %1, off\n\ts_mov_b32 m0, %0" : "=&s"(keep) : "v"(gsrc), "s"(lds_dst) : "memory"); }
#define ATT_WAITV(n) asm volatile("s_waitcnt vmcnt(" #n ")" ::: "memory")
template <bool SPLIT>
__device__ __forceinline__ void attn_a_unit(ATT_LAS unsigned char* lds, const ATensors& T, int b, int h, int qb, float negM, float lam, const int wid0) {
    constexpr int NKS = 3, NVS = SPLIT ? 4 : 3; typedef ALay<NKS, NVS> L;
    const int tid_ = wid0 * 64 + fresh_lane();
    const int tid = tid_, lane = tid & 63, r32 = lane & 31, hi = lane >> 5;
    const int wid = wid0;
    const bool late = SPLIT && wid >= 4;
    const size_t rowbase = (size_t)b * SEQ;
    const int q0 = qb * 256 + wid * 32;
    ATT_LAS float* wsf = (ATT_LAS float*)(lds + L::SCR) + wid * 64;
    const int krow_ = wid * 8 + (lane >> 3), kc = (lane & 7) ^ ((krow_ >> 1) & 7);
    const bf16_t* kg = T.K + (rowbase + krow_) * 1024 + h * 128 + kc * 8;
    const int vrow_ = wid * 4 + (lane >> 4), vc_ = (lane & 15) ^ ((vrow_ & 3) << 2);
    const bf16_t* vg = T.V + (rowbase + vrow_) * 1024 + h * 128 + vc_ * 8;
    const unsigned lds0 = (unsigned)(unsigned long)lds;
#define A_DMA(tile, kslot, vslot) do { const int t1_ = (tile) & 63, c1_ = (tile) >> 6; \
        glds16(kg + (size_t)t1_ * 64 * 1024 + c1_ * 64, (unsigned)__builtin_amdgcn_readfirstlane(lds0 + L::K0 + (kslot) * L::KST + wid * 1024)); \
        glds16(vg + (size_t)t1_ * 64 * 1024, (unsigned)__builtin_amdgcn_readfirstlane(lds0 + L::V0 + (vslot) * L::VST + wid * 1024)); \
        glds16(vg + (size_t)t1_ * 64 * 1024 + 32 * 1024, (unsigned)__builtin_amdgcn_readfirstlane(lds0 + L::V0 + (vslot) * L::VST + 8192 + wid * 1024)); } while (0)
    int ko[4], vo[4];
#pragma unroll
    for (int d0 = 0; d0 < 4; ++d0) ko[d0] = r32 * 128 + (((2 * d0 + hi) ^ ((r32 >> 1) & 7)) << 4);
    { const int q = (lane & 15) >> 2, g = (lane >> 4) & 1, p = lane & 3;
#pragma unroll
      for (int db = 0; db < 4; ++db) vo[db] = (4 * hi + q) * 256 + ((((db ^ q) << 2) | (2 * g + (p >> 1))) << 4) + 8 * (p & 1); }
    const bf16_t* qp = T.Q + (rowbase + q0 + r32) * 1024 + h * 128 + hi * 8;
    f32x16 negm;
#pragma unroll
    for (int r = 0; r < 16; ++r) negm[r] = negM;
    A_DMA(0, 0, 0); A_DMA(1, 1, 1);
    ATT_WAITV(3); __builtin_amdgcn_s_barrier();
    f32x16 o[4];
    ATT_LAS unsigned* o0s = (ATT_LAS unsigned*)(lds + L::O0) + wid * 2048 + lane;
    bf16x8 qr[4], pa[4];
    float lsum = 0.f;
    int ks = 0, vs = 0, vsp = 0;
    for (int tt = 0; tt <= 128; ++tt) {
        int ks2 = ks + 2; ks2 = ks2 >= NKS ? ks2 - NKS : ks2; int vs2 = vs + 2; vs2 = vs2 >= NVS ? vs2 - NVS : vs2;
        if (tt + 2 < 128) A_DMA(tt + 2, ks2, vs2);
        if (late && tt > 0) a_pv(lds + L::V0 + vsp * L::VST, vo, pa, o);
        if (tt == 64) {
            const float l = add_x32(lsum);
            if (hi == 0) wsf[r32] = __builtin_amdgcn_rcpf(l);
            asm volatile("s_waitcnt lgkmcnt(0)" ::: "memory");
#pragma unroll
            for (int r = 0; r < 8; ++r) { const float l0 = wsf[crow(2 * r, hi)], l1 = wsf[crow(2 * r + 1, hi)];
#pragma unroll
                for (int db = 0; db < 4; ++db) o0s[(db * 8 + r) * 64] = cvtpk(o[db][2 * r] * l0, o[db][2 * r + 1] * l1); }
            asm volatile("s_waitcnt lgkmcnt(0)" ::: "memory");
        }
        if (tt == 128) {
            const float l = add_x32(lsum);
            if (hi == 0) wsf[r32] = __builtin_amdgcn_rcpf(l);
            asm volatile("s_waitcnt lgkmcnt(0)" ::: "memory");
            const float g0 = T.subln_g[r32], g1 = T.subln_g[32 + r32], g2 = T.subln_g[64 + r32], g3 = T.subln_g[96 + r32];
            const float post = 1.0f - T.lam_init;
#pragma unroll
            for (int r = 0; r < 16; ++r) {
                const float li = wsf[crow(r, hi)] * lam;
                float d[4], sq = 0.f;
#pragma unroll
                for (int db = 0; db < 4; ++db) { const unsigned w = o0s[(db * 8 + (r >> 1)) * 64]; const float a0 = __uint_as_float((r & 1) ? (w & 0xffff0000u) : (w << 16)); d[db] = a0 - o[db][r] * li; sq += d[db] * d[db]; }
                sq += shx<1>(sq); sq += shx<2>(sq); sq += shx<4>(sq); sq += shx<8>(sq); sq += shx<16>(sq);
                const float rn = __builtin_amdgcn_rsqf(sq * (1.0f / 128.0f) + 1e-6f) * post;
                bf16_t* op = T.O + (rowbase + q0 + crow(r, hi)) * 1024 + h * 128 + r32;
                const float v0 = d[0] * rn * g0, v1 = d[1] * rn * g1, v2 = d[2] * rn * g2, v3 = d[3] * rn * g3;
                op[0] = (bf16_t)(cvtpk(v0, v0) & 0xffffu); op[32] = (bf16_t)(cvtpk(v1, v1) & 0xffffu); op[64] = (bf16_t)(cvtpk(v2, v2) & 0xffffu); op[96] = (bf16_t)(cvtpk(v3, v3) & 0xffffu);
            }
            asm volatile("s_waitcnt vmcnt(0) lgkmcnt(0)" ::: "memory");
        }
        if (tt < 128) {
            if ((tt & 63) == 0) {
                const int c = tt >> 6;
#pragma unroll
                for (int d0 = 0; d0 < 4; ++d0) qr[d0] = *(const bf16x8*)(qp + c * 64 + d0 * 16);
                asm volatile("" : "+v"(qr[0]), "+v"(qr[1]), "+v"(qr[2]), "+v"(qr[3]));
#pragma unroll
                for (int db = 0; db < 4; ++db)
#pragma unroll
                    for (int r = 0; r < 16; ++r) o[db][r] = 0.f;
                lsum = 0.f;
            }
            a_qk_exp(lds + L::K0 + ks * L::KST, ko, qr, negm, pa, lsum);
            if (!late) a_pv(lds + L::V0 + vs * L::VST, vo, pa, o);
        }
        if (tt + 2 < 128) ATT_WAITV(3); else ATT_WAITV(0);
        asm volatile("s_waitcnt lgkmcnt(0)" ::: "memory");
        __builtin_amdgcn_s_barrier();
        vsp = vs; ks = ks + 1 >= NKS ? 0 : ks + 1; vs = vs + 1 >= NVS ? 0 : vs + 1;
    }
#undef A_DMA
}

struct A2Lay { static constexpr int KST = 16384, VST = 16384, K0 = 0, V0 = 2 * KST, Q0 = V0 + 2 * VST, SCR = Q0 + 8 * 8192, END = SCR + 8 * 256; };
__device__ __forceinline__ void a2_qk_half(const ATT_LAS unsigned char* ks, const ATT_LAS unsigned char* qs, const int (&ko)[4], bf16x8& pa_lo, bf16x8& pa_hi, float& lsum) {
    const f32x16 zero = {0.f, 0.f, 0.f, 0.f, 0.f, 0.f, 0.f, 0.f, 0.f, 0.f, 0.f, 0.f, 0.f, 0.f, 0.f, 0.f};
    bf16x8 q[4], k[4];
#pragma unroll
    for (int d0 = 0; d0 < 4; ++d0) { q[d0] = *(const ATT_LAS bf16x8*)(qs + ko[d0]); k[d0] = *(const ATT_LAS bf16x8*)(ks + ko[d0]); }
    f32x16 p = __builtin_amdgcn_mfma_f32_32x32x16_bf16(k[0], q[0], zero, 0, 0, 0);
#pragma unroll
    for (int d0 = 1; d0 < 4; ++d0) p = __builtin_amdgcn_mfma_f32_32x32x16_bf16(k[d0], q[d0], p, 0, 0, 0);
    float sa = 0.f, sb = 0.f;
#pragma unroll
    for (int r = 0; r < 16; r += 2) { p[r] = __builtin_amdgcn_exp2f(p[r]); p[r + 1] = __builtin_amdgcn_exp2f(p[r + 1]); sa += p[r]; sb += p[r + 1]; }
    pa_lo = pack_p(p, 0); pa_hi = pack_p(p, 1);
    lsum += sa + sb;
    __builtin_amdgcn_sched_barrier(0);
}
#define A2_EXP4(P, g, sa, sb) do { P[4 * (g)] = __builtin_amdgcn_exp2f(P[4 * (g)]); P[4 * (g) + 1] = __builtin_amdgcn_exp2f(P[4 * (g) + 1]); P[4 * (g) + 2] = __builtin_amdgcn_exp2f(P[4 * (g) + 2]); \
        P[4 * (g) + 3] = __builtin_amdgcn_exp2f(P[4 * (g) + 3]); sa += P[4 * (g)] + P[4 * (g) + 2]; sb += P[4 * (g) + 1] + P[4 * (g) + 3]; } while (0)
#define A2_LD1(kk, qq, kb_, qb_, d0) do { kk = *(const ATT_LAS bf16x8*)((kb_) + ko[d0]); qq = *(const ATT_LAS bf16x8*)((qb_) + ko[d0]); } while (0)
__device__ __forceinline__ void a2_qk_pair(const ATT_LAS unsigned char* k0b, const ATT_LAS unsigned char* k1b, const ATT_LAS unsigned char* q0b, const ATT_LAS unsigned char* q1b, const int (&ko)[4],
                                           bf16x8& pm0a, bf16x8& pm0b, bf16x8& pm1a, bf16x8& pm1b, float& ls0, float& ls1) {
    const f32x16 zero = {0.f, 0.f, 0.f, 0.f, 0.f, 0.f, 0.f, 0.f, 0.f, 0.f, 0.f, 0.f, 0.f, 0.f, 0.f, 0.f};
    bf16x8 ka, qa, kb, qb2; f32x16 pA, pB; float sa = 0.f, sb = 0.f;
    A2_LD1(ka, qa, k0b, q0b, 0); A2_LD1(kb, qb2, k0b, q0b, 1);
    pA = __builtin_amdgcn_mfma_f32_32x32x16_bf16(ka, qa, zero, 0, 0, 0);
    __builtin_amdgcn_sched_barrier(0);
    A2_LD1(ka, qa, k0b, q0b, 2);
    pA = __builtin_amdgcn_mfma_f32_32x32x16_bf16(kb, qb2, pA, 0, 0, 0);
    __builtin_amdgcn_sched_barrier(0);
    A2_LD1(kb, qb2, k0b, q0b, 3);
    pA = __builtin_amdgcn_mfma_f32_32x32x16_bf16(ka, qa, pA, 0, 0, 0);
    __builtin_amdgcn_sched_barrier(0);
    A2_LD1(ka, qa, k1b, q1b, 0);
    pA = __builtin_amdgcn_mfma_f32_32x32x16_bf16(kb, qb2, pA, 0, 0, 0);
    __builtin_amdgcn_sched_barrier(0);
    A2_LD1(kb, qb2, k1b, q1b, 1);
    __builtin_amdgcn_sched_barrier(0);
    pB = __builtin_amdgcn_mfma_f32_32x32x16_bf16(ka, qa, zero, 0, 0, 0); A2_EXP4(pA, 0, sa, sb); __builtin_amdgcn_sched_barrier(0);
    A2_LD1(ka, qa, k1b, q1b, 2); __builtin_amdgcn_sched_barrier(0);
    pB = __builtin_amdgcn_mfma_f32_32x32x16_bf16(kb, qb2, pB, 0, 0, 0); A2_EXP4(pA, 1, sa, sb); __builtin_amdgcn_sched_barrier(0);
    A2_LD1(kb, qb2, k1b, q1b, 3); __builtin_amdgcn_sched_barrier(0);
    pB = __builtin_amdgcn_mfma_f32_32x32x16_bf16(ka, qa, pB, 0, 0, 0); A2_EXP4(pA, 2, sa, sb); __builtin_amdgcn_sched_barrier(0);
    pB = __builtin_amdgcn_mfma_f32_32x32x16_bf16(kb, qb2, pB, 0, 0, 0); A2_EXP4(pA, 3, sa, sb); __builtin_amdgcn_sched_barrier(0);
    pm0a = pack_p(pA, 0); pm0b = pack_p(pA, 1);
    ls0 += sa + sb; sa = 0.f; sb = 0.f;
#pragma unroll
    for (int g = 0; g < 4; ++g) A2_EXP4(pB, g, sa, sb);
    pm1a = pack_p(pB, 0); pm1b = pack_p(pB, 1);
    ls1 += sa + sb;
    __builtin_amdgcn_sched_barrier(0);
}
#define A2_PV2(s0_, p0a, p0b, p1a, p1b) do { \
        bf16x8 vc[4], vn[4]; \
        _Pragma("unroll") for (int db = 0; db < 4; ++db) vc[db] = vfrag(vs + vo[db] + (s0_) * 16 * 256, 8 * 256); \
        _Pragma("unroll") for (int db = 0; db < 4; ++db) vn[db] = vfrag(vs + vo[db] + ((s0_) + 1) * 16 * 256, 8 * 256); \
        __builtin_amdgcn_sched_barrier(0); \
        _Pragma("unroll") for (int db = 0; db < 4; ++db) { o0[db] = __builtin_amdgcn_mfma_f32_32x32x16_bf16(p0a, vc[db], o0[db], 0, 0, 0); o1[db] = __builtin_amdgcn_mfma_f32_32x32x16_bf16(p1a, vc[db], o1[db], 0, 0, 0); } \
        __builtin_amdgcn_sched_barrier(0); \
        _Pragma("unroll") for (int db = 0; db < 4; ++db) { o0[db] = __builtin_amdgcn_mfma_f32_32x32x16_bf16(p0b, vn[db], o0[db], 0, 0, 0); o1[db] = __builtin_amdgcn_mfma_f32_32x32x16_bf16(p1b, vn[db], o1[db], 0, 0, 0); } \
        __builtin_amdgcn_sched_barrier(0); } while (0)
__device__ __forceinline__ void attn_a_unit2(ATT_LAS unsigned char* lds, const ATensors& T, int b, int h, int qb, float lam, const int wid0) {
    typedef A2Lay L;
    const int lane = fresh_lane(), r32 = lane & 31, hi = lane >> 5, wid = wid0;
    const size_t rowbase = (size_t)b * SEQ;
    const int q0 = qb * 256 + wid * 32;
    const int krow_ = wid * 8 + (lane >> 3), kc = (lane & 7) ^ ((krow_ >> 1) & 7);
    const unsigned koff = (unsigned)((rowbase + krow_) * 1024 + h * 128 + kc * 8);
    const int vrow_ = wid * 4 + (lane >> 4), vc_ = (lane & 15) ^ ((vrow_ & 3) << 2);
    const unsigned voff = (unsigned)((rowbase + vrow_) * 1024 + h * 128 + vc_ * 8);
    const unsigned lds0 = (unsigned)(unsigned long)lds;
#define A2_DMA(tile, slot) do { \
        glds16(T.K + (size_t)(koff + (unsigned)(tile) * 65536u), (unsigned)__builtin_amdgcn_readfirstlane(lds0 + L::K0 + (slot) * L::KST + wid * 1024)); \
        glds16(T.K + (size_t)(koff + (unsigned)(tile) * 65536u + 64u), (unsigned)__builtin_amdgcn_readfirstlane(lds0 + L::K0 + (slot) * L::KST + 8192 + wid * 1024)); \
        glds16(T.V + (size_t)(voff + (unsigned)(tile) * 65536u), (unsigned)__builtin_amdgcn_readfirstlane(lds0 + L::V0 + (slot) * L::VST + wid * 1024)); \
        glds16(T.V + (size_t)(voff + (unsigned)(tile) * 65536u + 32768u), (unsigned)__builtin_amdgcn_readfirstlane(lds0 + L::V0 + (slot) * L::VST + 8192 + wid * 1024)); } while (0)
#pragma unroll
    for (int i = 0; i < 8; ++i) { const int c = i >> 2, m = (i & 3) * 64 + lane, row = m >> 3, gch = (m & 7) ^ ((row >> 1) & 7);
        glds16(T.Q + (rowbase + q0 + row) * 1024 + h * 128 + c * 64 + gch * 8, (unsigned)__builtin_amdgcn_readfirstlane(lds0 + L::Q0 + wid * 8192 + i * 1024)); }
    A2_DMA(0, 0);
    f32x16 o0[4], o1[4];
#pragma unroll
    for (int db = 0; db < 4; ++db)
#pragma unroll
        for (int r = 0; r < 16; ++r) { o0[db][r] = 0.f; o1[db][r] = 0.f; }
    float ls0 = 0.f, ls1 = 0.f;
    ATT_WAITV(0); __builtin_amdgcn_s_barrier();
    const ATT_LAS unsigned char* qbase = lds + L::Q0 + wid * 8192;
    for (int t = 0; t < 64; ++t) {
        const int slot = t & 1;
        if (t + 1 < 64) A2_DMA(t + 1, slot ^ 1);
        {
            const ATT_LAS unsigned char* k0 = lds + L::K0 + slot * L::KST;
            const ATT_LAS unsigned char* vs = lds + L::V0 + slot * L::VST;
            int vo[4];
            { const int ln2 = fresh_lane(), q = (ln2 & 15) >> 2, g = (ln2 >> 4) & 1, p = ln2 & 3, h2 = ln2 >> 5;
#pragma unroll
              for (int db = 0; db < 4; ++db) vo[db] = (4 * h2 + q) * 256 + ((((db ^ q) << 2) | (2 * g + (p >> 1))) << 4) + 8 * (p & 1); }
            int ko[4];
            { const int ln3 = fresh_lane(), r3 = ln3 & 31, h3 = ln3 >> 5;
#pragma unroll
              for (int d0 = 0; d0 < 4; ++d0) ko[d0] = r3 * 128 + (((2 * d0 + h3) ^ ((r3 >> 1) & 7)) << 4); }
            bf16x8 p0a, p0b, p1a, p1b;
            a2_qk_pair(k0, k0 + 8192, qbase, qbase + 4096, ko, p0a, p0b, p1a, p1b, ls0, ls1);
            A2_PV2(0, p0a, p0b, p1a, p1b);
            a2_qk_pair(k0 + 32 * 128, k0 + 8192 + 32 * 128, qbase, qbase + 4096, ko, p0a, p0b, p1a, p1b, ls0, ls1);
            A2_PV2(2, p0a, p0b, p1a, p1b);
        }
        ATT_WAITV(0);
        asm volatile("s_waitcnt lgkmcnt(0)" ::: "memory");
        __builtin_amdgcn_s_barrier();
    }
#undef A2_DMA
    {
        const int ln = fresh_lane(), r32f = ln & 31, hif = ln >> 5;
        ATT_LAS float* wsf2 = (ATT_LAS float*)(lds + L::SCR) + wid * 64;
        const float l0 = add_x32_(ls0), l1 = add_x32_(ls1);
        if (hif == 0) { wsf2[r32f] = __builtin_amdgcn_rcpf(l0); wsf2[32 + r32f] = __builtin_amdgcn_rcpf(l1) * lam; }
        asm volatile("s_waitcnt lgkmcnt(0)" ::: "memory");
        const float g0 = T.subln_g[r32f], g1 = T.subln_g[32 + r32f], g2 = T.subln_g[64 + r32f], g3 = T.subln_g[96 + r32f];
        float lin = T.lam_init; asm volatile("" : "+v"(lin));
        const float post = 1.0f - lin;
#pragma unroll
        for (int r = 0; r < 16; ++r) {
            const float li0 = wsf2[crow(r, hif)], li1 = wsf2[32 + crow(r, hif)];
            float d[4], sq = 0.f;
#pragma unroll
            for (int db = 0; db < 4; ++db) { d[db] = o0[db][r] * li0 - o1[db][r] * li1; sq += d[db] * d[db]; }
            sq += shx<1>(sq); sq += shx<2>(sq); sq += shx<4>(sq); sq += shx<8>(sq); sq += shx<16>(sq);
            const float rn = __builtin_amdgcn_rsqf(sq * (1.0f / 128.0f) + 1e-6f) * post;
            ATT_LAS bf16_t* op = (ATT_LAS bf16_t*)(lds + L::Q0 + wid * 8192 + crow(r, hif) * 256) + r32f;
            const float v0 = d[0] * rn * g0, v1 = d[1] * rn * g1, v2 = d[2] * rn * g2, v3 = d[3] * rn * g3;
            op[0] = (bf16_t)(cvtpk(v0, v0) & 0xffffu); op[32] = (bf16_t)(cvtpk(v1, v1) & 0xffffu); op[64] = (bf16_t)(cvtpk(v2, v2) & 0xffffu); op[96] = (bf16_t)(cvtpk(v3, v3) & 0xffffu);
        }
        asm volatile("s_waitcnt lgkmcnt(0)" ::: "memory");
#pragma unroll
        for (int it = 0; it < 8; ++it) { const int c = it * 64 + ln, row = c >> 4, ch = c & 15;
            const u32x4 w = *(const ATT_LAS u32x4*)(lds + L::Q0 + wid * 8192 + row * 256 + ch * 16);
            *(u32x4*)(T.O + (rowbase + q0 + row) * 1024 + h * 128 + ch * 8) = w; }
        asm volatile("s_waitcnt vmcnt(0) lgkmcnt(0)" ::: "memory");
        __builtin_amdgcn_s_barrier();
    }
}

struct BTensors {
    const bf16_t* Q; const bf16_t* K; const bf16_t* V;
    bf16_t* O;
};
constexpr int B_ACC = 8 * B_STAGE + 8 * 256;
constexpr int B_LACC = B_ACC + 512 * 64 * 2;
constexpr int B_LDS2 = B_LACC + 512 * 4;
__device__ __forceinline__ void b_load(const BTensors& T, size_t rowbase, int j, int g, int lg, int rg, int p0, int lane, bf16x8 (&kf)[4], u32x4 (&vr)[4]) {
    const int r32 = lane & 31, hi = lane >> 5, L = SEQ >> lg;
    int pk = p0 + r32; pk = pk < 0 ? 0 : (pk >= L ? L - 1 : pk);
    const bf16_t* kp = T.K + (rowbase + ((size_t)pk << lg) + rg) * 768 + g * 256 + j * 64 + hi * 8;
#pragma unroll
    for (int d0 = 0; d0 < 4; ++d0) kf[d0] = *(const bf16x8*)(kp + d0 * 16);
#pragma unroll
    for (int it = 0; it < 4; ++it) { const int idx = it * 64 + lane, row = idx >> 3, chk = idx & 7;
        int pv = p0 + row; pv = pv < 0 ? 0 : (pv >= L ? L - 1 : pv);
        vr[it] = *(const u32x4*)(T.V + (rowbase + ((size_t)pv << lg) + rg) * 768 + g * 256 + j * 64 + chk * 8); }
}
__device__ __forceinline__ void attn_b_block(ATT_LAS unsigned char* lds, const BTensors& T, int b, int j, int blk, const int wid0) {
    const int lane = fresh_lane(), r32 = lane & 31, hi = lane >> 5, wid = wid0;
    ATT_LAS unsigned char* stage = lds + wid * B_STAGE;
    ATT_LAS float* wsf = (ATT_LAS float*)(lds + 8 * B_STAGE) + wid * 64;
    ATT_LAS unsigned short* acc = (ATT_LAS unsigned short*)(lds + B_ACC);
    ATT_LAS float* lacc = (ATT_LAS float*)(lds + B_LACC);
    const size_t rowbase = (size_t)b * SEQ;
    const int vfo = (4 * hi + ((lane & 15) >> 2)) * VPB + (((lane >> 4) & 1) * 16 + (lane & 3) * 4) * 2;
    const f32x16 zero = {0.f, 0.f, 0.f, 0.f, 0.f, 0.f, 0.f, 0.f, 0.f, 0.f, 0.f, 0.f, 0.f, 0.f, 0.f, 0.f};
    for (int g = 0; g < 3; ++g) {
        const int lg = 2 * g, dil = 1 << lg, L = SEQ >> lg;
        for (int rd = 0; rd < 2; ++rd) {
            const int item = wid + 8 * rd, rg = item & (dil - 1), bb = item >> lg;
            const int pbase = ((blk * 512) >> lg) + 32 * bb;
            const int pq = pbase + r32;
            const int tl0 = rg + ((32 * bb) << lg);
            bf16x8 qr[4], kf[4], kn[4]; u32x4 vr[4], vn[4];
            { const bf16_t* qp = T.Q + (rowbase + blk * 512 + tl0 + (r32 << lg)) * 768 + g * 256 + j * 64 + hi * 8;
#pragma unroll
              for (int d0 = 0; d0 < 4; ++d0) qr[d0] = *(const bf16x8*)(qp + d0 * 16); }
            f32x16 o[2] = {zero, zero};
            float lsum = 0.f;
            b_load(T, rowbase, j, g, lg, rg, pbase - 64, lane, kf, vr);
#pragma unroll
            for (int ch = 0; ch < 5; ++ch) {
                const int p0 = pbase - 64 + 32 * ch;
                if (ch + 1 < 5) b_load(T, rowbase, j, g, lg, rg, p0 + 32, lane, kn, vn);
                asm volatile("s_waitcnt lgkmcnt(0)" ::: "memory");
#pragma unroll
                for (int it = 0; it < 4; ++it) { const int i2 = it * 64 + lane, row = i2 >> 3, chk = i2 & 7;
                    *(ATT_LAS u32x4*)(stage + row * VPB + chk * 16) = vr[it]; }
                f32x16 p = __builtin_amdgcn_mfma_f32_32x32x16_bf16(kf[0], qr[0], zero, 0, 0, 0);
#pragma unroll
                for (int d0 = 1; d0 < 4; ++d0) p = __builtin_amdgcn_mfma_f32_32x32x16_bf16(kf[d0], qr[d0], p, 0, 0, 0);
                float sacc = 0.f;
                const bool full = (ch >= 1 && ch <= 3) && (p0 >= 0) && (p0 + 31 < L);
                if (full) {
#pragma unroll
                    for (int x = 0; x < 16; ++x) { p[x] = __builtin_amdgcn_exp2f(p[x]); sacc += p[x]; }
                } else {
                    const int lo = max(pq - 64, 0) - (p0 + 4 * hi), span = min(pq + 64, L - 1) - (p0 + 4 * hi) - lo;
#pragma unroll
                    for (int x = 0; x < 16; ++x) {
                        const int cx = (x & 3) + 8 * (x >> 2);
                        const bool ok = (unsigned)(cx - lo) <= (unsigned)span;
                        const float e = __builtin_amdgcn_exp2f(p[x]);
                        p[x] = ok ? e : 0.f; sacc += p[x];
                    }
                }
                lsum += sacc;
                asm volatile("s_waitcnt lgkmcnt(0)" ::: "memory");
#pragma unroll
                for (int s2 = 0; s2 < 2; ++s2) {
                    const bf16x8 pa = pack_p(p, s2);
#pragma unroll
                    for (int db = 0; db < 2; ++db) {
                        const bf16x8 vf = vfrag(stage + vfo + s2 * 16 * VPB + db * 64, 8 * VPB);
                        o[db] = __builtin_amdgcn_mfma_f32_32x32x16_bf16(pa, vf, o[db], 0, 0, 0);
                    }
                }
#pragma unroll
                for (int d0 = 0; d0 < 4; ++d0) { kf[d0] = kn[d0]; vr[d0] = vn[d0]; }
            }
            const float l = add_x32_(lsum);
            if (g == 0) {
                if (hi == 0) lacc[tl0 + (r32 << lg)] = l;
#pragma unroll
                for (int x = 0; x < 16; ++x) { const int tl = tl0 + (crow(x, hi) << lg);
                    acc[tl * 64 + r32] = (unsigned short)(cvtpk(o[0][x], o[0][x]) & 0xffffu); acc[tl * 64 + 32 + r32] = (unsigned short)(cvtpk(o[1][x], o[1][x]) & 0xffffu); }
            } else if (g == 1) {
                if (hi == 0) lacc[tl0 + (r32 << lg)] += l;
#pragma unroll
                for (int x = 0; x < 16; ++x) { const int tl = tl0 + (crow(x, hi) << lg);
                    const float a0 = __uint_as_float((unsigned)acc[tl * 64 + r32] << 16) + o[0][x], a1 = __uint_as_float((unsigned)acc[tl * 64 + 32 + r32] << 16) + o[1][x];
                    acc[tl * 64 + r32] = (unsigned short)(cvtpk(a0, a0) & 0xffffu); acc[tl * 64 + 32 + r32] = (unsigned short)(cvtpk(a1, a1) & 0xffffu); }
            } else {
                if (hi == 0) wsf[r32] = l + lacc[tl0 + (r32 << lg)];
                asm volatile("s_waitcnt lgkmcnt(0)" ::: "memory");
#pragma unroll
                for (int x = 0; x < 16; ++x) { const int tl = tl0 + (crow(x, hi) << lg);
                    const float li = __builtin_amdgcn_rcpf(wsf[crow(x, hi)]);
                    const float a0 = (__uint_as_float((unsigned)acc[tl * 64 + r32] << 16) + o[0][x]) * li, a1 = (__uint_as_float((unsigned)acc[tl * 64 + 32 + r32] << 16) + o[1][x]) * li;
                    ATT_LAS bf16_t* op = (ATT_LAS bf16_t*)(stage + crow(x, hi) * 128) + r32;
                    op[0] = (bf16_t)(cvtpk(a0, a0) & 0xffffu); op[32] = (bf16_t)(cvtpk(a1, a1) & 0xffffu); }
                asm volatile("s_waitcnt lgkmcnt(0)" ::: "memory");
#pragma unroll
                for (int it = 0; it < 4; ++it) { const int c = it * 64 + lane, qrow = c >> 3, ch = c & 7;
                    const u32x4 w = *(const ATT_LAS u32x4*)(stage + qrow * 128 + ch * 16);
                    *(u32x4*)(T.O + (rowbase + blk * 512 + tl0 + (qrow << lg)) * 256 + j * 64 + ch * 8) = w; }
                asm volatile("s_waitcnt lgkmcnt(0)" ::: "memory");
            }
        }
        __syncthreads();
    }
}
}

namespace cg = cooperative_groups;
#define LAS __attribute__((address_space(3)))
typedef unsigned short bf16;
typedef float f32x4 __attribute__((ext_vector_type(4)));
typedef unsigned v4u __attribute__((ext_vector_type(4)));
constexpr int NWAVES = 8, NTHREADS = 512;
constexpr int BATCH = 8, SEQ = 4096, D = 1024, T = BATCH * SEQ, FF = 4096, DEPTH = 2;
constexpr int IN_COLS = 7424, QKV_COLS = 5376;
constexpr size_t MiB = 1u << 20;
constexpr size_t WS_ROWSS = 1 * MiB;
constexpr size_t WS_MOD = WS_ROWSS + 4 * (size_t)T * 4;
constexpr size_t WS_SBIN = WS_MOD + 2 * 8 * 6144 * 4;
constexpr size_t WS_SBUP = WS_SBIN + 2 * 8 * 7424 * 4;
constexpr size_t WS_COS = 3 * MiB, WS_SIN = 4 * MiB;
constexpr size_t WS_WT = 6 * MiB;
constexpr size_t WT_IN = 0, WT_A = WT_IN + (size_t)IN_COLS * D, WT_B = WT_A + (size_t)D * D, WT_OUT = WT_B + (size_t)D * 256, WT_UP = WT_OUT + (size_t)D * D, WT_DN = WT_UP + (size_t)FF * D, WT_LAYER = WT_DN + (size_t)D * FF;
constexpr size_t WS_QA = 76 * MiB, WS_KA = 140 * MiB, WS_VA = 204 * MiB, WS_QB = 268 * MiB, WS_KB = 316 * MiB, WS_VB = 364 * MiB, WS_XS = 412 * MiB, WS_OB = 476 * MiB, WS_END = 492 * MiB;
constexpr size_t WS_TMP1 = 140 * MiB, WS_GA = 268 * MiB, WS_U = 332 * MiB, WS_H = 76 * MiB;
static_assert(WS_WT + 2 * WT_LAYER * 2 <= WS_QA, "weights fit");
static_assert(WS_SBUP + 2 * 8 * 4096 * 4 <= WS_COS, "small fits");
#ifndef ATT_SPLIT
#define ATT_SPLIT true
#endif
constexpr int LDS_BYTES = 163840;
static_assert(att::A_LDS <= LDS_BYTES && att::B_LDS2 <= LDS_BYTES && att::A2Lay::END <= LDS_BYTES - 64, "LDS");

#define XB_TMO      128
#define XB_XCNT(j)  (256  + 64 * (j))
#define XB_XSUB(j)  (1280 + 64 * (j))
#define XB_XGEN(j)  (2304 + 64 * (j))
#define XB_TOP      3328
#define XB_TOPGEN   3392
#define XCD_BAR_WORDS 3456
#define XB_SPIN_CAP (1u << 18)

__device__ __forceinline__ unsigned xb_ld(unsigned* p)              { return __hip_atomic_load(p, __ATOMIC_RELAXED, __HIP_MEMORY_SCOPE_AGENT); }
__device__ __forceinline__ unsigned xb_add(unsigned* p, unsigned v) { return __hip_atomic_fetch_add(p, v, __ATOMIC_RELAXED, __HIP_MEMORY_SCOPE_AGENT); }
__device__ __forceinline__ unsigned xb_xcc_id() { return (unsigned)__builtin_amdgcn_s_getreg((3 << 11) | 20) & 0xFu; }
#define XB_SPIN(cond, bar) do { unsigned _sp = 0; while (cond) { __builtin_amdgcn_s_sleep(1); \
    if ((++_sp & 255u) == 0u) { if (xb_ld(&(bar)[XB_TMO])) break; if (_sp > XB_SPIN_CAP) { atomicAdd(&(bar)[XB_TMO], 1u); break; } } } } while (0)

struct XcdBarrier {
    unsigned* bar; unsigned x;
    volatile __attribute__((address_space(3))) unsigned* st;
};

__device__ __forceinline__ XcdBarrier xcd_barrier_post(unsigned* bar, volatile __attribute__((address_space(3))) unsigned* st, bool leader) {
    XcdBarrier b; b.bar = bar; b.x = xb_xcc_id(); b.st = st;
    if (leader) (void)xb_add(&bar[XB_XCNT(b.x)], 1u);
    return b;
}
__device__ __forceinline__ void xcd_barrier_complete(unsigned* bar, unsigned x, unsigned& nloc, unsigned& nx) {
    const unsigned G = gridDim.x * gridDim.y * gridDim.z;
    unsigned sum, cnt, mine, sp = 0u;
    for (;;) {
        sum = 0u; cnt = 0u; mine = 0u;
#pragma unroll
        for (unsigned j = 0; j < 16; ++j) { const unsigned c = xb_ld(&bar[XB_XCNT(j)]); sum += c; cnt += (c > 0u) ? 1u : 0u; mine = (j == x) ? c : mine; }
        if (sum == G) break;
        __builtin_amdgcn_s_sleep(1);
        if ((++sp & 255u) == 0u) { if (xb_ld(&bar[XB_TMO])) break; if (sp > XB_SPIN_CAP) { atomicAdd(&bar[XB_TMO], 1u); break; } }
    }
    nloc = mine > 0u ? mine : 1u; nx = cnt > 0u ? cnt : 1u;
}

__device__ __forceinline__ void xcd_barrier(const XcdBarrier& b, bool leader) {
    asm volatile("s_waitcnt vmcnt(0)" ::: "memory");
    __syncthreads();
    if (leader) {
        unsigned* bar = b.bar; unsigned myx = b.x; asm volatile("" : "+s"(bar), "+s"(myx));
        __builtin_amdgcn_s_waitcnt(0);
        unsigned nloc = b.st[0], nx = b.st[1];
        if (nloc == 0u) { xcd_barrier_complete(bar, myx, nloc, nx); b.st[0] = nloc; b.st[1] = nx; }
        const unsigned old = xb_add(&bar[XB_XSUB(myx)], 1u);
        const unsigned gen = old / nloc;
        if (old + 1u == (gen + 1u) * nloc) {
            __builtin_amdgcn_fence(__ATOMIC_RELEASE, "agent");
            asm volatile("s_waitcnt vmcnt(0)" ::: "memory");
            const unsigned og = xb_add(&bar[XB_TOP], 1u);
            const unsigned tg = og / nx;
            if (og + 1u == (tg + 1u) * nx) xb_add(&bar[XB_TOPGEN], 1u);
            else XB_SPIN(xb_ld(&bar[XB_TOPGEN]) == tg, bar);
            __builtin_amdgcn_fence(__ATOMIC_ACQUIRE, "agent");
            xb_add(&bar[XB_XGEN(myx)], 1u);
            asm volatile("s_waitcnt vmcnt(0)" ::: "memory");
        } else {
            XB_SPIN(xb_ld(&bar[XB_XGEN(myx)]) == gen, bar);
            __builtin_amdgcn_fence(__ATOMIC_ACQUIRE, "agent");
            asm volatile("s_waitcnt vmcnt(0)" ::: "memory");
        }
    }
    __syncthreads();
}

struct Args {
    const float *x, *c; const int* pos;
    const float *ada_w, *ada_b, *norm_mix_g, *norm_mlp_g, *w_in, *qk_gain_a, *lambda_a, *subln_g_a, *qk_gain_b, *w_branch_a, *w_branch_b, *gate_bias, *w_out, *w_mlp_up, *w_mlp_down;
    float* out; unsigned char* ws;
};

__device__ __forceinline__ unsigned f2bf(float f) { unsigned u = __builtin_bit_cast(unsigned, f); return (u + 0x7fffu + ((u >> 16) & 1u)) >> 16; }
__device__ __forceinline__ unsigned pk2(float lo, float hi) { return f2bf(lo) | (f2bf(hi) << 16); }

__device__ __forceinline__ void conv_item(const float* W, int K, int N, bf16* WT, int perm_limit, LAS float* scr, int item, const int wid0) {
    const int tid = wid0 * 64 + fresh_lane(); const int nblk = N / 64, kb = item / nblk, nb = item % nblk, k0 = 256 * kb, n0 = 64 * nb;
    float r[32];
#pragma unroll
    for (int i = 0; i < 32; ++i) { const int kk = i * 8 + (tid >> 6), nn = tid & 63; r[i] = W[(size_t)(k0 + kk) * N + n0 + nn]; }
#pragma unroll
    for (int i = 0; i < 32; ++i) { const int kk = i * 8 + (tid >> 6), nn = tid & 63; scr[kk * 65 + nn] = r[i]; }
    __syncthreads();
    { const int n = tid >> 3, c = tid & 7;
      int col = n0 + n;
      if (col < perm_limit) { const int tile = col >> 8, nl = col & 255, wc = nl >> 6, bj = (nl >> 5) & 1, j = nl & 31; col = tile * 256 + 128 * bj + 32 * wc + j; }
#pragma unroll
      for (int hk = 0; hk < 4; ++hk) { const LAS float* s = scr + (64 * hk + 8 * c) * 65 + n;
          v4u o; o.x = pk2(s[0], s[65]); o.y = pk2(s[2 * 65], s[3 * 65]); o.z = pk2(s[4 * 65], s[5 * 65]); o.w = pk2(s[6 * 65], s[7 * 65]);
          *(v4u*)(WT + (size_t)col * K + k0 + 64 * hk + 8 * c) = o; } }
    __syncthreads();
}
__device__ __forceinline__ void gemv8_item(const float* W, int N, const float* bias, float* out, int ldo, int n0, const LAS float* in_s, LAS float* red, const int wid0) {
    const int lane = fresh_lane(), wid = wid0, tid = wid0 * 64 + lane;
    float a0[8], a1[8];
#pragma unroll
    for (int b = 0; b < 8; ++b) { a0[b] = 0.f; a1[b] = 0.f; }
    const float* wp = W + (size_t)(128 * wid) * N + n0 + 2 * lane;
#pragma unroll 32
    for (int k = 0; k < 128; ++k) {
        const float2 w = *(const float2*)(wp + (size_t)k * N);
        const f32x4 i0 = *(const LAS f32x4*)(in_s + (128 * wid + k) * 8), i1 = *(const LAS f32x4*)(in_s + (128 * wid + k) * 8 + 4);
#pragma unroll
        for (int b = 0; b < 4; ++b) { a0[b] += i0[b] * w.x; a1[b] += i0[b] * w.y; a0[4 + b] += i1[b] * w.x; a1[4 + b] += i1[b] * w.y; }
    }
#pragma unroll
    for (int b = 0; b < 8; ++b) { red[(wid * 8 + b) * 128 + 2 * lane] = a0[b]; red[(wid * 8 + b) * 128 + 2 * lane + 1] = a1[b]; }
    __syncthreads();
#pragma unroll
    for (int i = 0; i < 2; ++i) { const int o = tid + i * 512, b = o >> 7, c = o & 127; float s = bias ? bias[n0 + c] : 0.f;
#pragma unroll
        for (int w = 0; w < 8; ++w) s += red[(w * 8 + b) * 128 + c];
        out[(size_t)b * ldo + n0 + c] = s; }
    __syncthreads();
}

__global__ void __launch_bounds__(NTHREADS, 2) fwd_megakernel(Args a) {
    extern __shared__ __attribute__((aligned(16))) unsigned char lds_raw[];
    LAS unsigned char* lds = (LAS unsigned char*)lds_raw;
    cg::grid_group grid = cg::this_grid();
    const int wid0 = __builtin_amdgcn_readfirstlane(threadIdx.x >> 6);
#define FRESH_IDS() const int lane = fresh_lane(), wid = wid0, tid = wid0 * 64 + lane; (void)lane; (void)wid; (void)tid
    const int G = gridDim.x, bx = blockIdx.x;
    unsigned char* ws = a.ws;
    volatile LAS unsigned* bar_st = (volatile LAS unsigned*)(lds + LDS_BYTES - 64);
    { const bool ld0 = (wid0 == 0) && (fresh_lane() == 0); if (ld0) { bar_st[0] = 0u; bar_st[1] = 0u; } __syncthreads(); }
    XcdBarrier xbar = xcd_barrier_post((unsigned*)ws, bar_st, (wid0 == 0) && (fresh_lane() == 0));
    if ((wid0 == 0) && (fresh_lane() == 0)) bar_st[2] = atomicAdd((unsigned*)ws + 3584 + 64 * xbar.x, 1u);
#define GRID_BAR() xcd_barrier(xbar, (wid0 == 0) && (fresh_lane() == 0))
    float* rowss = (float*)(ws + WS_ROWSS); float* mod = (float*)(ws + WS_MOD); float* sbin = (float*)(ws + WS_SBIN); float* sbup = (float*)(ws + WS_SBUP);
    float* cosT = (float*)(ws + WS_COS); float* sinT = (float*)(ws + WS_SIN);
    bf16* WT = (bf16*)(ws + WS_WT);
    bf16 *QA = (bf16*)(ws + WS_QA), *KA = (bf16*)(ws + WS_KA), *VA = (bf16*)(ws + WS_VA), *QB = (bf16*)(ws + WS_QB), *KB = (bf16*)(ws + WS_KB), *VB = (bf16*)(ws + WS_VB);
    bf16 *XS = (bf16*)(ws + WS_XS), *OB = (bf16*)(ws + WS_OB), *GA = (bf16*)(ws + WS_GA), *U = (bf16*)(ws + WS_U), *H = (bf16*)(ws + WS_H);
    bf16* TMP1 = (bf16*)(ws + WS_TMP1);

    {
        FRESH_IDS();
        LAS float* scr = (LAS float*)lds;
        constexpr int I_IN = 4 * (IN_COLS / 64), I_A = 4 * 16, I_B = 1 * 16, I_OUT = 4 * 16, I_UP = 4 * 64, I_DN = 16 * 16, I_L = I_IN + I_A + I_B + I_OUT + I_UP + I_DN;
        for (int it = bx; it < 2 * I_L; it += G) {
            const int l = it / I_L; int r = it % I_L; bf16* wt = WT + (size_t)l * WT_LAYER;
            if (r < I_IN) { conv_item(a.w_in + (size_t)l * D * IN_COLS, D, IN_COLS, wt + WT_IN, QKV_COLS, scr, r, wid0); continue; } r -= I_IN;
            if (r < I_A) { conv_item(a.w_branch_a + (size_t)l * D * D, D, D, wt + WT_A, 0, scr, r, wid0); continue; } r -= I_A;
            if (r < I_B) { conv_item(a.w_branch_b + (size_t)l * 256 * D, 256, D, wt + WT_B, 0, scr, r, wid0); continue; } r -= I_B;
            if (r < I_OUT) { conv_item(a.w_out + (size_t)l * D * D, D, D, wt + WT_OUT, 0, scr, r, wid0); continue; } r -= I_OUT;
            if (r < I_UP) { conv_item(a.w_mlp_up + (size_t)l * D * FF, D, FF, wt + WT_UP, 0, scr, r, wid0); continue; } r -= I_UP;
            conv_item(a.w_mlp_down + (size_t)l * FF * D, FF, D, wt + WT_DN, 0, scr, r, wid0);
        }
        {
            LAS float* in_s = (LAS float*)lds; LAS float* red = (LAS float*)(lds + 32768);
            bool filled = false;
            for (int it = bx; it < 2 * 48; it += G) {
                if (!filled) { for (int i = tid; i < 8192; i += NTHREADS) { const int k = i >> 3, b = i & 7; const float v = a.c[b * D + k]; in_s[i] = v / (1.0f + __expf(-v)); } __syncthreads(); filled = true; }
                const int l = it / 48, nb = it % 48;
                gemv8_item(a.ada_w + (size_t)l * D * 6144, 6144, a.ada_b + l * 6144, mod + l * 8 * 6144, 6144, nb * 128, in_s, red, wid0);
            }
            __syncthreads();
        }
        for (int i = bx * NTHREADS + tid; i < T * 8; i += G * NTHREADS) {
            const int t = i >> 3, f = i & 7;
            float fr = 1.0f;
            fr = (f == 1) ? 0.19392274474868576f : fr; fr = (f == 2) ? 0.03760603093086393f : fr; fr = (f == 3) ? 0.007292664737217109f : fr; fr = (f == 4) ? 0.001414213562373095f : fr;
            fr = (f == 5) ? 0.0002742481756762073f : fr; fr = (f == 6) ? 5.318295896944988e-05f : fr; fr = (f == 7) ? 1.031338537721246e-05f : fr;
            const float ang = (float)a.pos[t] * fr;
            const double ad = (double)ang; const double kk = __builtin_rint(ad * 0.15915494309189535); const float rd = (float)(ad - kk * 6.283185307179586);
            cosT[i] = __cosf(rd); sinT[i] = __sinf(rd);
        }
        for (int i = bx * NTHREADS + tid; i < 3 * T; i += G * NTHREADS) rowss[T + i] = 0.f;
    }
    grid.sync();
    int vb_ = bx;
    if (G == 256) { bool even = true; for (int j = 0; j < 8; ++j) even = even && (__hip_atomic_load((unsigned*)ws + 3584 + 64 * j, __ATOMIC_RELAXED, __HIP_MEMORY_SCOPE_AGENT) == 32u);
        if (even) vb_ = (int)bar_st[2] * 8 + (int)xbar.x; }
    const int vb = __builtin_amdgcn_readfirstlane(vb_);
    {
        FRESH_IDS();
        LAS float* in_s = (LAS float*)lds; LAS float* red = (LAS float*)(lds + 32768);
        constexpr int NI_IN = IN_COLS / 128, NI_UP = FF / 128, NI_L = NI_IN + NI_UP;
        for (int it = vb; it < 2 * NI_L; it += G) {
            const int l = it / NI_L, r = it % NI_L; const bool up = r >= NI_IN;
            const float* sh = mod + l * 8 * 6144 + (up ? 3 * 1024 : 0);
            for (int i = tid; i < 8192; i += NTHREADS) { const int k = i >> 3, b = i & 7; in_s[i] = sh[b * 6144 + k]; }
            __syncthreads();
            if (!up) gemv8_item(a.w_in + (size_t)l * D * IN_COLS, IN_COLS, nullptr, sbin + l * 8 * IN_COLS, IN_COLS, r * 128, in_s, red, wid0);
            else gemv8_item(a.w_mlp_up + (size_t)l * D * FF, FF, nullptr, sbup + l * 8 * FF, FF, (r - NI_IN) * 128, in_s, red, wid0);
        }
        const int gw = vb * NWAVES + wid, NGW = G * NWAVES;
        for (int m0 = gw; m0 < T; m0 += 2 * NGW) {
            f32x4 v[2][4], sc[2][4];
#pragma unroll
            for (int rr = 0; rr < 2; ++rr) { const int mv = m0 + rr * NGW, m = mv < T ? mv : m0, b = m >> 12;
                const f32x4* xr = (const f32x4*)(a.x + (size_t)m * D) + lane; const f32x4* sr = (const f32x4*)(mod + b * 6144 + 1024) + lane;
#pragma unroll
                for (int j = 0; j < 4; ++j) { v[rr][j] = xr[64 * j]; sc[rr][j] = sr[64 * j]; } }
            const f32x4* gr = (const f32x4*)(a.norm_mix_g) + lane;
#pragma unroll
            for (int rr = 0; rr < 2; ++rr) { const int mv = m0 + rr * NGW, m = mv < T ? mv : m0;
                unsigned long long* o8 = (unsigned long long*)(XS + (size_t)m * D) + lane;
                float s = 0.f;
#pragma unroll
                for (int j = 0; j < 4; ++j) { const f32x4 x4 = v[rr][j]; s += (x4.x * x4.x + x4.y * x4.y) + (x4.z * x4.z + x4.w * x4.w);
                    const f32x4 w = x4 * gr[64 * j] * (sc[rr][j] + 1.0f);
                    o8[64 * j] = (unsigned long long)pk2(w.x, w.y) | ((unsigned long long)pk2(w.z, w.w) << 32); }
                s = att::wave_sum(s);
                if (lane == 0) rowss[m] = s; }
        }
    }
    GRID_BAR();

    for (int l = 0; l < DEPTH; ++l) {
        const bf16* wt = WT + (size_t)l * WT_LAYER;
        const float* modl = mod + l * 8 * 6144;
        const float* rs_mix = rowss + (size_t)(2 * l) * T; float* rs_mlp = rowss + (size_t)(2 * l + 1) * T;
        {
            pg8::Gemm g{XS, wt + WT_IN, T, QKV_COLS, D}; pg8::StaticOrder S; S.init(T, QKV_COLS, G, vb);
            pg8::EpiQKV E{QA, KA, VA, QB, KB, VB, rs_mix, sbin + l * 8 * IN_COLS, a.qk_gain_a + l * 128, a.qk_gain_b + l * 128, cosT, sinT};
            pg8::gemm_phase<pg8::EpiQKV, pg8::StaticOrder, true, true>(lds, g, S, E, wid0);
        }
        GRID_BAR();
        {
            FRESH_IDS();
            const float ga_q = att::wave_max(fabsf(a.qk_gain_a[l * 128 + lane])), ga_k = att::wave_max(fabsf(a.qk_gain_a[l * 128 + 64 + lane]));
            const float gb_q = att::wave_max(fabsf(a.qk_gain_b[l * 128 + lane])), gb_k = att::wave_max(fabsf(a.qk_gain_b[l * 128 + 64 + lane]));
            const float negMa = -(pg8::QK_C2 * 64.0f) * ga_q * ga_k, negMb = -(pg8::QK_C2 * 64.0f) * gb_q * gb_k;
            const float lam_init = __int_as_float(__builtin_amdgcn_readfirstlane(__float_as_int(0.8f - 0.6f * expf(-0.3f * (float)l))));
            const float* lv = a.lambda_a + l * 256;
            const float d1 = att::wave_sum(lv[lane] * lv[64 + lane]), d2 = att::wave_sum(lv[128 + lane] * lv[192 + lane]);
            const float lam = __int_as_float(__builtin_amdgcn_readfirstlane(__float_as_int(expf(d1) - expf(d2) + lam_init)));
            {
                att::BTensors TB{QB, KB, VB, OB};
                for (int u = vb; u < 256; u += G) { const int gidx = (G == 256) ? ((u & 7) * 32 + (u >> 3)) : u; att::attn_b_block(lds, TB, gidx >> 5, (gidx >> 3) & 3, gidx & 7, wid0); }
                __syncthreads();
            }
            {
                att::ATensors TA{QA, KA, VA, QA, a.qk_gain_a + l * 128, lv, a.subln_g_a + l * 128, lam_init};
#ifdef PROBE_A2
                { att::ATensors TD{QA, KA, VA, U, a.qk_gain_a + l * 128, lv, a.subln_g_a + l * 128, lam_init};
                  const int x = vb & 7, idx = vb >> 3;
                  for (int rd = 0; rd < 4; ++rd) { const int pr = rd * 16 + x * 2 + (idx >> 4); att::attn_a_unit2(lds, TD, pr >> 3, pr & 7, idx & 15, lam, wid0); } }
#endif
                if (G == 256) {
                    const int x = vb & 7, idx = vb >> 3;
                    for (int rd = 0; rd < 4; ++rd) { const int pr = rd * 16 + x * 2 + (idx >> 4); att::attn_a_unit2(lds, TA, pr >> 3, pr & 7, idx & 15, lam, wid0); }
                } else
                for (int it = vb; it < 8 * 8 * 16; it += G) {
                    const int qb = it & 15, h = (it >> 4) & 7, b = it >> 7;
                    att::attn_a_unit2(lds, TA, b, h, qb, lam, wid0);
                }
            }
        }
        GRID_BAR();
        {
            pg8::StaticOrder S; S.init(T, D, G, vb);
            { pg8::Gemm g{XS, wt + WT_IN + (size_t)(QKV_COLS + 1024) * D, T, D, D};
              pg8::EpiGate<false> E{TMP1, rs_mix, sbin + l * 8 * IN_COLS + QKV_COLS + 1024, a.gate_bias + l * 2048 + 1024};
              pg8::gemm_phase<pg8::EpiGate<false>, pg8::StaticOrder, true, true>(lds, g, S, E, wid0); }
            { pg8::Gemm g{OB, wt + WT_B, T, D, 256}; pg8::EpiMulInPlace E{TMP1};
              pg8::gemm_phase<pg8::EpiMulInPlace, pg8::StaticOrder, true, true>(lds, g, S, E, wid0); }
            { pg8::Gemm g{XS, wt + WT_IN + (size_t)QKV_COLS * D, T, D, D};
              pg8::EpiGate<false> E{GA, rs_mix, sbin + l * 8 * IN_COLS + QKV_COLS, a.gate_bias + l * 2048};
              pg8::gemm_phase<pg8::EpiGate<false>, pg8::StaticOrder, true, true>(lds, g, S, E, wid0); }
            { pg8::Gemm g{QA, wt + WT_A, T, D, D}; pg8::EpiMerge E{TMP1, GA, U};
              pg8::gemm_phase<pg8::EpiMerge, pg8::StaticOrder, true, true>(lds, g, S, E, wid0); }
        }
        GRID_BAR();
        {
            pg8::Gemm g{U, wt + WT_OUT, T, D, D}; pg8::StaticOrder S; S.init(T, D, G, vb);
            pg8::EpiResid E{l == 0 ? a.x : a.out, a.out, modl + 2 * 1024, XS, a.norm_mlp_g + l * D, modl + 4 * 1024, rs_mlp};
            pg8::gemm_phase<pg8::EpiResid, pg8::StaticOrder, true, true>(lds, g, S, E, wid0);
        }
        GRID_BAR();
        {
            pg8::Gemm g{XS, wt + WT_UP, T, FF, D}; pg8::StaticOrder S; S.init(T, FF, G, vb);
            pg8::EpiUp E{H, rs_mlp, sbup + l * 8 * FF};
            pg8::gemm_phase<pg8::EpiUp, pg8::StaticOrder, true, true>(lds, g, S, E, wid0);
        }
        GRID_BAR();
        {
            pg8::Gemm g{H, wt + WT_DN, T, D, FF}; pg8::StaticOrder S; S.init(T, D, G, vb);
            const bool nxt = l + 1 < DEPTH;
            pg8::EpiResid E{a.out, a.out, modl + 5 * 1024, nxt ? XS : nullptr, a.norm_mix_g + (l + 1) * D, mod + (l + 1) * 8 * 6144 + 1024, rowss + (size_t)(2 * l + 2) * T};
            pg8::gemm_phase<pg8::EpiResid, pg8::StaticOrder, true, true>(lds, g, S, E, wid0);
        }
        if (l + 1 < DEPTH) GRID_BAR();
    }
}

extern "C" void kernel_launch(void* const* d_in, const int* in_sizes, int n_in, void* d_out, int out_size, void* d_ws, size_t ws_size, hipStream_t stream) {
    static int grid = 0;
    if (grid == 0) {
        if (n_in != 18 || out_size != T * D || ws_size < WS_END) { fprintf(stderr, "kernel_launch: unexpected shapes (n_in %d out %d ws %zu)\n", n_in, out_size, ws_size); grid = -1; return; }
        int dev = 0, cus = 0, per_cu = 0;
        hipGetDevice(&dev); hipDeviceGetAttribute(&cus, hipDeviceAttributeMultiprocessorCount, dev);
        if (hipFuncSetAttribute((const void*)fwd_megakernel, hipFuncAttributeMaxDynamicSharedMemorySize, LDS_BYTES) != hipSuccess) { fprintf(stderr, "kernel_launch: hipFuncSetAttribute failed\n"); grid = -1; return; }
        if (hipOccupancyMaxActiveBlocksPerMultiprocessor(&per_cu, (const void*)fwd_megakernel, NTHREADS, LDS_BYTES) != hipSuccess || per_cu < 1) { fprintf(stderr, "kernel_launch: occupancy query failed (%d)\n", per_cu); per_cu = 1; }
        (void)hipGetLastError();
        grid = cus * per_cu;
    }
    if (grid < 0) return;
    Args a{};
    a.x = (const float*)d_in[0]; a.c = (const float*)d_in[1]; a.pos = (const int*)d_in[2];
    a.ada_w = (const float*)d_in[3]; a.ada_b = (const float*)d_in[4]; a.norm_mix_g = (const float*)d_in[5]; a.norm_mlp_g = (const float*)d_in[6]; a.w_in = (const float*)d_in[7];
    a.qk_gain_a = (const float*)d_in[8]; a.lambda_a = (const float*)d_in[9]; a.subln_g_a = (const float*)d_in[10]; a.qk_gain_b = (const float*)d_in[11];
    a.w_branch_a = (const float*)d_in[12]; a.w_branch_b = (const float*)d_in[13]; a.gate_bias = (const float*)d_in[14]; a.w_out = (const float*)d_in[15];
    a.w_mlp_up = (const float*)d_in[16]; a.w_mlp_down = (const float*)d_in[17];
    a.out = (float*)d_out; a.ws = (unsigned char*)d_ws;
    if (hipMemsetAsync(d_ws, 0, 16384, stream) != hipSuccess) { fprintf(stderr, "kernel_launch: memset failed\n"); return; }
    void* args[] = {&a};
    hipError_t e = hipLaunchCooperativeKernel((const void*)fwd_megakernel, dim3(grid), dim3(NTHREADS), args, LDS_BYTES, stream);
    if (e != hipSuccess) fprintf(stderr, "cooperative launch failed: %s (grid %d)\n", hipGetErrorString(e), grid);
}
```
